# Optimizing an MI355X kernel written in HIP

```python
import jax, jax.numpy as jnp
from jax import lax
import numpy as np

D_MODEL = 1024
BATCH = 2
SEQ = 8192
DEPTH = 1

POOL_WIDTH = D_MODEL
POOL_WINDOWS = (2, 4, 8, 16)
N_POOL_GROUPS = len(POOL_WINDOWS)
POOL_GROUP_DIM = POOL_WIDTH // N_POOL_GROUPS
MLSTM_WIDTH = D_MODEL
N_HEADS = 4
HEAD_DIM = MLSTM_WIDTH // N_HEADS
QKV_BLOCK = 4
N_QKV_BLOCKS = MLSTM_WIDTH // QKV_BLOCK
CONV_K = 4
CHUNK = 128
MIX_WIDTH = POOL_WIDTH + MLSTM_WIDTH
IN_WIDTH = 2 * POOL_WIDTH + 3 * MLSTM_WIDTH
EPS = 1e-6

kernel_name = "hybrid_pool_mlstm_parallel_heads"


def rmsnorm(x, w):
    xf = x.astype(jnp.float32)
    y = xf * lax.rsqrt(jnp.mean(xf * xf, axis=-1, keepdims=True) + EPS)
    return (y * w.astype(jnp.float32)).astype(x.dtype)


def pool_mixer(u, pool_w, pool_scale):
    B, S, _ = u.shape
    uf = u.astype(jnp.float32)
    cs = jnp.cumsum(uf, axis=1)
    pos = jnp.arange(1, S + 1, dtype=jnp.float32)
    outs = []
    for g, win in enumerate(POOL_WINDOWS):
        sl = slice(g * POOL_GROUP_DIM, (g + 1) * POOL_GROUP_DIM)
        seg = cs[..., sl]
        prev = jnp.pad(seg, ((0, 0), (win, 0), (0, 0)))[:, :S]
        cnt = jnp.minimum(pos, float(win))[None, :, None]
        outs.append((seg - prev) / cnt - uf[..., sl])
    d = jnp.stack(outs, axis=2).astype(u.dtype)
    y = jnp.einsum('bsgc,gcd->bsgd', d, pool_w).reshape(B, S, POOL_WIDTH)
    return y * pool_scale


def causal_conv(u, w, b):
    S = u.shape[1]
    up = jnp.pad(u, ((0, 0), (CONV_K - 1, 0), (0, 0)))
    y = sum(up[:, j:j + S] * w[j] for j in range(CONV_K))
    return y + b


def headwise(u, w):
    B, S, C = u.shape
    return jnp.einsum('bsnc,ncd->bsnd', u.reshape(B, S, N_QKV_BLOCKS, QKV_BLOCK), w).reshape(B, S, C)


def mlstm_chunkwise(q, k, v, i_pre, f_pre):
    B, H, S, DH = q.shape
    NC = S // CHUNK
    q = q.reshape(B, H, NC, CHUNK, DH)
    k = k.reshape(B, H, NC, CHUNK, DH) * (DH ** -0.5)
    v = v.reshape(B, H, NC, CHUNK, DH)
    log_f = jax.nn.log_sigmoid(f_pre).reshape(B, H, NC, CHUNK)
    ig = i_pre.reshape(B, H, NC, CHUNK)
    b = jnp.cumsum(log_f, axis=-1)
    g = b[..., -1]
    a = g[..., None] - b + ig
    a_max = jnp.max(a, axis=-1)

    def step(carry, xs):
        C, n, m = carry
        k_c, v_c, a_c, g_c, amax_c = xs
        m_new = jnp.maximum(g_c + m, amax_c)
        decay = jnp.exp(g_c + m - m_new)
        w = jnp.exp(a_c - m_new[..., None])
        C_new = decay[..., None, None] * C + jnp.einsum('bhl,bhle,bhld->bhed', w, v_c, k_c)
        n_new = decay[..., None] * n + jnp.einsum('bhl,bhld->bhd', w, k_c)
        return (C_new, n_new, m_new), (C, n, m)

    init = (jnp.zeros((B, H, DH, DH), jnp.float32),
            jnp.zeros((B, H, DH), jnp.float32),
            jnp.zeros((B, H), jnp.float32))
    xs = (jnp.moveaxis(k, 2, 0), jnp.moveaxis(v, 2, 0), jnp.moveaxis(a, 2, 0),
          jnp.moveaxis(g, 2, 0), jnp.moveaxis(a_max, 2, 0))
    _, (C_s, n_s, m_s) = lax.scan(step, init, xs)
    C_s = jnp.moveaxis(C_s, 0, 2)
    n_s = jnp.moveaxis(n_s, 0, 2)
    m_s = jnp.moveaxis(m_s, 0, 2)

    mask = jnp.tril(jnp.ones((CHUNK, CHUNK), dtype=bool))
    d_log = b[..., :, None] - b[..., None, :] + ig[..., None, :]
    d_log = jnp.where(mask, d_log, -jnp.inf)
    m_inter = b + m_s[..., None]
    m_t = jnp.maximum(jnp.max(d_log, axis=-1), m_inter)
    W = jnp.exp(d_log - m_t[..., None]) * jnp.einsum('bhcld,bhcsd->bhcls', q, k)
    inter = jnp.exp(m_inter - m_t)
    num = jnp.einsum('bhcls,bhcse->bhcle', W, v) + inter[..., None] * jnp.einsum('bhced,bhcld->bhcle', C_s, q)
    den = jnp.sum(W, axis=-1) + inter * jnp.einsum('bhcd,bhcld->bhcl', n_s, q)
    h = num / jnp.maximum(jnp.abs(den), jnp.exp(-m_t))[..., None]
    return h.reshape(B, H, S, DH)


def mlstm_branch(mx, mz, mo, conv_w, conv_b, w_q, w_k, w_v, w_if, b_if, mh_norm_w, m_skip):
    B, S, _ = mx.shape
    xc = jax.nn.silu(causal_conv(mx, conv_w, conv_b))
    q = headwise(xc, w_q)
    k = headwise(xc, w_k)
    v = headwise(mx, w_v)
    gates = (jnp.concatenate([q, k, v], axis=-1) @ w_if + b_if).astype(jnp.float32)
    i_pre = jnp.transpose(gates[..., :N_HEADS], (0, 2, 1))
    f_pre = jnp.transpose(gates[..., N_HEADS:], (0, 2, 1))

    def to_heads(t):
        return jnp.transpose(t.astype(jnp.float32).reshape(B, S, N_HEADS, HEAD_DIM), (0, 2, 1, 3))

    h = mlstm_chunkwise(to_heads(q), to_heads(k), to_heads(v), i_pre, f_pre)
    h = jnp.transpose(h, (0, 2, 1, 3))
    h = jax.nn.sigmoid(mo.astype(jnp.float32)).reshape(B, S, N_HEADS, HEAD_DIM) * h
    mu = jnp.mean(h, axis=-1, keepdims=True)
    var = jnp.mean(jnp.square(h - mu), axis=-1, keepdims=True)
    hn = ((h - mu) * lax.rsqrt(var + EPS)).reshape(B, S, MLSTM_WIDTH) * mh_norm_w.astype(jnp.float32)
    out = (hn.astype(mx.dtype) + m_skip * xc) * jax.nn.silu(mz)
    return out


def setup_inputs(seed: int = 0) -> dict:
    key = jax.random.key(seed)
    ks = jax.random.split(key, 20)
    f32 = jnp.float32
    nrm = lambda k, shape, s: jax.random.normal(k, shape, f32) * s
    x = jax.random.normal(ks[0], (BATCH, SEQ, D_MODEL), f32)
    norm_w = 1.0 + nrm(ks[1], (DEPTH, D_MODEL), 0.02)
    w_in = nrm(ks[2], (DEPTH, D_MODEL, IN_WIDTH), D_MODEL ** -0.5)
    pool_w = nrm(ks[3], (DEPTH, N_POOL_GROUPS, POOL_GROUP_DIM, POOL_GROUP_DIM), POOL_GROUP_DIM ** -0.5)
    pool_scale = 1.0 + nrm(ks[4], (DEPTH, POOL_WIDTH), 0.02)
    conv_w = nrm(ks[5], (DEPTH, CONV_K, MLSTM_WIDTH), CONV_K ** -0.5)
    conv_b = nrm(ks[6], (DEPTH, MLSTM_WIDTH), 0.02)
    w_q = nrm(ks[7], (DEPTH, N_QKV_BLOCKS, QKV_BLOCK, QKV_BLOCK), QKV_BLOCK ** -0.5)
    w_k = nrm(ks[8], (DEPTH, N_QKV_BLOCKS, QKV_BLOCK, QKV_BLOCK), QKV_BLOCK ** -0.5)
    w_v = nrm(ks[9], (DEPTH, N_QKV_BLOCKS, QKV_BLOCK, QKV_BLOCK), QKV_BLOCK ** -0.5)
    w_if = nrm(ks[10], (DEPTH, 3 * MLSTM_WIDTH, 2 * N_HEADS), 0.1 * (3 * MLSTM_WIDTH) ** -0.5)
    i_bias = nrm(ks[11], (DEPTH, N_HEADS), 0.1)
    f_bias = jnp.broadcast_to(jnp.linspace(3.0, 6.0, N_HEADS, dtype=f32), (DEPTH, N_HEADS)) + nrm(ks[12], (DEPTH, N_HEADS), 0.1)
    b_if = jnp.concatenate([i_bias, f_bias], axis=-1)
    mh_norm_w = 1.0 + nrm(ks[13], (DEPTH, MLSTM_WIDTH), 0.02)
    m_skip = 1.0 + nrm(ks[14], (DEPTH, MLSTM_WIDTH), 0.02)
    w_out = nrm(ks[15], (DEPTH, MIX_WIDTH, D_MODEL), MIX_WIDTH ** -0.5)
    final_norm_w = 1.0 + nrm(ks[16], (D_MODEL,), 0.02)
    return {"x": x, "norm_w": norm_w, "w_in": w_in, "pool_w": pool_w, "pool_scale": pool_scale,
            "conv_w": conv_w, "conv_b": conv_b, "w_q": w_q, "w_k": w_k, "w_v": w_v,
            "w_if": w_if, "b_if": b_if, "mh_norm_w": mh_norm_w, "m_skip": m_skip,
            "w_out": w_out, "final_norm_w": final_norm_w}


def reference(x, norm_w, w_in, pool_w, pool_scale, conv_w, conv_b, w_q, w_k, w_v,
              w_if, b_if, mh_norm_w, m_skip, w_out, final_norm_w):
    P, M = POOL_WIDTH, MLSTM_WIDTH
    for l in range(DEPTH):
        u = rmsnorm(x, norm_w[l])
        proj = u @ w_in[l]
        pool_x = proj[..., :P]
        pool_z = proj[..., P:2 * P]
        m_x = proj[..., 2 * P:2 * P + M]
        m_z = proj[..., 2 * P + M:2 * P + 2 * M]
        m_o = proj[..., 2 * P + 2 * M:]
        y_pool = pool_mixer(pool_x, pool_w[l], pool_scale[l]) * jax.nn.silu(pool_z)
        y_mlstm = mlstm_branch(m_x, m_z, m_o, conv_w[l], conv_b[l], w_q[l], w_k[l], w_v[l],
                               w_if[l], b_if[l], mh_norm_w[l], m_skip[l])
        mixed = jnp.concatenate([y_pool, y_mlstm], axis=-1)
        x = x + mixed @ w_out[l]
    return rmsnorm(x, final_norm_w)
```

```cpp
#include <hip/hip_runtime.h>
#include <hip/hip_cooperative_groups.h>
#include <cstdio>
#include <cstdint>
namespace cg = cooperative_groups;

#ifndef MK_MULTI
#define MK_MULTI 0
#endif

namespace pg8 {
#define PG8_LAS __attribute__((address_space(3)))
typedef unsigned short bf16_t;
typedef short bf16x8 __attribute__((ext_vector_type(8)));
typedef float f32x4 __attribute__((ext_vector_type(4)));
typedef unsigned u32x4 __attribute__((ext_vector_type(4)));
constexpr int BM = 256, BK = 64, HALF = 128, HTB = HALF * BK * 2, STAGE_BYTES = 8 * HTB, NXCD = 8, WGM = 8;

__host__ __device__ __forceinline__ int lds_byte(int r, int c) { const int st = (r >> 4) * 2 + (c >> 5), rr = r & 15, cc = c & 31, ob = rr * 64 + cc * 2; return st * 1024 + (ob ^ (((ob >> 9) & 1) << 5)); }
__host__ __device__ __forceinline__ void stage_rc(int b, int& R, int& C) { const int st = b / 1024, sb = b % 1024, swz = sb ^ (((sb >> 9) & 1) << 5); R = (st >> 1) * 16 + swz / 64; C = (st & 1) * 32 + (swz % 64) / 2; }
__host__ __device__ __forceinline__ int perm32(int rho) { const int n = rho >> 4, i = rho & 15; return 8 * (i >> 2) + 4 * n + (i & 3); }

struct Unit { int pm, pn; };
struct Gemm { const bf16_t* A; const bf16_t* Bt; int M, N, K, lda, ldb; };

struct StaticOrder {
    int nM, nN, nwg, G, c;
    __host__ __device__ void init(int M, int N, int G_, int c_) { nM = M / BM; nN = N / BM; nwg = nM * nN; G = G_; c = c_; }
    __host__ __device__ bool next(int i, Unit& u) const {
        const long L = (long)i * G + c; if (L >= nwg) return false;
        int wgid = (int)L; { const int q = nwg / NXCD, r = nwg % NXCD, xcd = wgid % NXCD, off = wgid / NXCD; wgid = (xcd < r ? xcd * (q + 1) : r * (q + 1) + (xcd - r) * q) + off; }
        const int nig = WGM * nN, gid = wgid / nig, fm = gid * WGM, gsz = (nM - fm) < WGM ? (nM - fm) : WGM;
        u.pm = fm + ((wgid % nig) % gsz); u.pn = (wgid % nig) / gsz; return true;
    }
};

__device__ __forceinline__ unsigned cvt_pk_bf16(float lo, float hi) { unsigned r; asm volatile("v_cvt_pk_bf16_f32 %0, %1, %2" : "=v"(r) : "v"(lo), "v"(hi)); return r; }

struct EpiProj {
    static constexpr bool PERM = true;
    bf16_t* O; int ldc; const float* rstd;
    __device__ __forceinline__ void operator()(const f32x4 (&acc)[2][2][4][2], const Unit& u, int wr, int wc, int fr, int fq) const {
        const int row0 = u.pm * BM + wr * 64 + fr; const int col0 = u.pn * BM + wc * 32 + 8 * fq;
#pragma unroll
        for (int ai = 0; ai < 2; ++ai)
#pragma unroll
            for (int m = 0; m < 4; ++m) { const int row = row0 + ai * HALF + m * 16; const float sc = rstd[row]; bf16_t* rowp = O + (size_t)row * ldc + col0;
#pragma unroll
                for (int bj = 0; bj < 2; ++bj) { f32x4 v0 = acc[ai][bj][m][0] * sc, v1 = acc[ai][bj][m][1] * sc;
                    u32x4 w; w.x = cvt_pk_bf16(v0[0], v0[1]); w.y = cvt_pk_bf16(v0[2], v0[3]); w.z = cvt_pk_bf16(v1[0], v1[1]); w.w = cvt_pk_bf16(v1[2], v1[3]);
                    *(u32x4*)(rowp + bj * HALF) = w; } }
    }
};
struct EpiResid {
    static constexpr bool PERM = false;
    const float* base; float* out; int ldc;
    __device__ __forceinline__ void operator()(const f32x4 (&acc)[2][2][4][2], const Unit& u, int wr, int wc, int fr, int fq) const {
        const int col0 = u.pn * BM + wc * 32 + 4 * fq;
#pragma unroll
        for (int ai = 0; ai < 2; ++ai)
#pragma unroll
            for (int m = 0; m < 4; ++m) { const size_t off = (size_t)(u.pm * BM + ai * HALF + wr * 64 + m * 16 + fr) * ldc + col0;
#pragma unroll
                for (int bj = 0; bj < 2; ++bj)
#pragma unroll
                    for (int n = 0; n < 2; ++n) { const f32x4 bs = *(const f32x4*)(base + off + bj * HALF + n * 16); *(f32x4*)(out + off + bj * HALF + n * 16) = bs + acc[ai][bj][m][n]; } }
    }
};

template <class Epi, class Sched>
__device__ __forceinline__ void gemm_phase(PG8_LAS unsigned char* lds, const Gemm g, const Sched& S, const Epi& E) {
    const int tid = threadIdx.x, wid = __builtin_amdgcn_readfirstlane(tid >> 6), lane = tid & 63, wr = wid >> 2, wc = wid & 3, fr = lane & 15, fq = lane >> 4;
    const int K = g.K, nt = K / BK;
    unsigned voffA[2], voffB[2];
#pragma unroll
    for (int i = 0; i < 2; ++i) { int R, C; stage_rc(tid * 16 + i * 8192, R, C); const int Rb = Epi::PERM ? ((R & ~31) + perm32(R & 31)) : R;
        voffA[i] = (unsigned)(R * g.lda + C) * 2u; voffB[i] = (unsigned)(Rb * g.ldb + C) * 2u; }
    const size_t kstep = (size_t)(BK * 2);
    const size_t hA = (size_t)HALF * g.lda * 2, hB = (size_t)HALF * g.ldb * 2;
    const size_t tA = 2 * hA, tB = 2 * hB;
    const unsigned ldsw = (unsigned)wid * 1024u;
    const int aoff = lds_byte(wr * 64 + fr, fq * 8), boff = lds_byte(wc * 32 + fr, fq * 8);
#define PG8_SA(b, h) (((b) * 2 + (h)) * HTB)
#define PG8_SB(b, h) ((4 + (b) * 2 + (h)) * HTB)
#define PG8_STAGE(bufoff, gbase, voff) do { _Pragma("unroll") for (int _i = 0; _i < 2; ++_i) \
        __builtin_amdgcn_global_load_lds((const unsigned*)((const char*)(gbase) + (voff)[_i]), (PG8_LAS unsigned*)(lds + (bufoff) + ldsw + _i * 8192), 16, 0, 0); } while (0)
#define PG8_LDA(dst, b, h) do { _Pragma("unroll") for (int m = 0; m < 4; ++m) _Pragma("unroll") for (int k = 0; k < 2; ++k) dst[m][k] = *(const PG8_LAS bf16x8*)(lds + PG8_SA(b, h) + aoff + m * 2048 + k * 1024); } while (0)
#define PG8_LDB(dst, b, h) do { _Pragma("unroll") for (int n = 0; n < 2; ++n) _Pragma("unroll") for (int k = 0; k < 2; ++k) dst[n][k] = *(const PG8_LAS bf16x8*)(lds + PG8_SB(b, h) + boff + n * 2048 + k * 1024); } while (0)
#define PG8_MMA(ai, bj, At, Bt) do { __builtin_amdgcn_s_setprio(1); _Pragma("unroll") for (int m = 0; m < 4; ++m) _Pragma("unroll") for (int n = 0; n < 2; ++n) _Pragma("unroll") for (int k = 0; k < 2; ++k) \
        acc[ai][bj][m][n] = __builtin_amdgcn_mfma_f32_16x16x32_bf16(Bt[n][k], At[m][k], acc[ai][bj][m][n], 0, 0, 0); __builtin_amdgcn_s_setprio(0); } while (0)
#define PG8_WAIT_V(n) asm volatile("s_waitcnt vmcnt(" #n ")" ::: "memory")
#define PG8_WAIT_L(n) asm volatile("s_waitcnt lgkmcnt(" #n ")" ::: "memory")
#define PG8_BAR __builtin_amdgcn_s_barrier()
#define PG8_SCHED __builtin_amdgcn_sched_barrier(0)
    Unit cur, nxt; int ui = 0;
    if (!S.next(0, cur)) return;
    f32x4 acc[2][2][4][2];
#pragma unroll
    for (int a = 0; a < 2; ++a)
#pragma unroll
        for (int b = 0; b < 2; ++b)
#pragma unroll
            for (int m = 0; m < 4; ++m)
#pragma unroll
                for (int n = 0; n < 2; ++n) acc[a][b][m][n] = (f32x4){0.f, 0.f, 0.f, 0.f};
    bf16x8 At[4][2], B0[2][2], B1[2][2];
    const char* cA = (const char*)g.A + (size_t)cur.pm * tA; const char* cB = (const char*)g.Bt + (size_t)cur.pn * tB;
    PG8_STAGE(PG8_SB(0, 0), cB, voffB); PG8_STAGE(PG8_SB(0, 1), cB + hB, voffB); PG8_STAGE(PG8_SA(0, 0), cA, voffA); PG8_STAGE(PG8_SA(0, 1), cA + hA, voffA);
    if (wr == 1) PG8_BAR;
    PG8_WAIT_V(2); PG8_BAR;
    PG8_STAGE(PG8_SB(1, 0), cB + kstep, voffB); PG8_STAGE(PG8_SA(1, 0), cA + kstep, voffA); PG8_STAGE(PG8_SB(1, 1), cB + hB + kstep, voffB);
    PG8_WAIT_V(6); PG8_BAR;
    for (;;) {
        const bool has_next = S.next(ui + 1, nxt);
        const char* nA = has_next ? (const char*)g.A + (size_t)nxt.pm * tA : cA; const char* nB = has_next ? (const char*)g.Bt + (size_t)nxt.pn * tB : cB;
        for (int t = 0; t < nt; t += 2) {
            const bool last = (t == nt - 2);
            const char* a1 = cA + (size_t)(t + 1) * kstep;
            const char* a2 = last ? nA : cA + (size_t)(t + 2) * kstep; const char* b2 = last ? nB : cB + (size_t)(t + 2) * kstep;
            const char* a3 = a2 + kstep; const char* b3 = b2 + kstep;
            PG8_LDB(B0, 0, 0); PG8_LDB(B1, 0, 1); PG8_SCHED; PG8_LDA(At, 0, 0); PG8_STAGE(PG8_SA(1, 1), a1 + hA, voffA);
            PG8_WAIT_V(8); PG8_WAIT_L(0); PG8_BAR; PG8_MMA(0, 0, At, B0); PG8_MMA(0, 1, At, B1); PG8_BAR; PG8_SCHED;
            PG8_LDA(At, 0, 1); PG8_STAGE(PG8_SB(0, 0), b2, voffB); PG8_STAGE(PG8_SB(0, 1), b2 + hB, voffB); PG8_STAGE(PG8_SA(0, 0), a2, voffA);
            PG8_WAIT_V(8); PG8_WAIT_L(0); PG8_BAR; PG8_MMA(1, 0, At, B0); PG8_MMA(1, 1, At, B1); PG8_BAR; PG8_SCHED;
            PG8_LDB(B0, 1, 0); PG8_LDB(B1, 1, 1); PG8_SCHED; PG8_LDA(At, 1, 0); PG8_STAGE(PG8_SA(0, 1), a2 + hA, voffA);
            PG8_WAIT_V(8); PG8_WAIT_L(0); PG8_BAR; PG8_MMA(0, 0, At, B0); PG8_MMA(0, 1, At, B1); PG8_BAR; PG8_SCHED;
            PG8_LDA(At, 1, 1); PG8_STAGE(PG8_SB(1, 0), b3, voffB); PG8_STAGE(PG8_SB(1, 1), b3 + hB, voffB); PG8_STAGE(PG8_SA(1, 0), a3, voffA);
            PG8_WAIT_V(8); PG8_WAIT_L(0); PG8_BAR; PG8_MMA(1, 0, At, B0); PG8_MMA(1, 1, At, B1); PG8_BAR; PG8_SCHED;
        }
        if (wr == 0) PG8_BAR;
        E(acc, cur, wr, wc, fr, fq);
        if (!has_next) break;
#pragma unroll
        for (int a = 0; a < 2; ++a)
#pragma unroll
            for (int b = 0; b < 2; ++b)
#pragma unroll
                for (int m = 0; m < 4; ++m)
#pragma unroll
                    for (int n = 0; n < 2; ++n) acc[a][b][m][n] = (f32x4){0.f, 0.f, 0.f, 0.f};
        cur = nxt; cA = nA; cB = nB; ++ui;
        if (wr == 1) PG8_BAR;
    }
    PG8_WAIT_V(0);
    PG8_BAR;
#undef PG8_SA
#undef PG8_SB
#undef PG8_STAGE
#undef PG8_LDA
#undef PG8_LDB
#undef PG8_MMA
#undef PG8_WAIT_V
#undef PG8_WAIT_L
#undef PG8_BAR
#undef PG8_SCHED
}
}

typedef unsigned short bf16;
typedef short bf16x8 __attribute__((ext_vector_type(8)));
typedef float f32x4 __attribute__((ext_vector_type(4)));
typedef unsigned u32x4 __attribute__((ext_vector_type(4)));
typedef unsigned u32x2 __attribute__((ext_vector_type(2)));

constexpr int NWAVES = 8, NTHR = 512;
constexpr int SEQ = 8192, NB = 2, T = NB * SEQ, DM = 1024, NIN = 5120, LDP = NIN;
constexpr int NH = 4, DH = 256, CHK = 128, NCH = SEQ / CHK, NITEM = NB * NH * NCH;
constexpr int C_PY = 0, C_MX = 1024, C_PZ = 2048, C_MZ = 3072, C_MO = 4096;
constexpr float EPS = 1e-6f;
constexpr size_t MiB = 1u << 20;
constexpr size_t WS_GXC = 0, WS_GMX = 32768, WS_GC = 65536, WS_AMAX = 65536 + 4096, WS_MS = 65536 + 8192;
constexpr size_t WS_RSTD = 1 * MiB, WS_GATES = 2 * MiB, WS_NLOC = 3 * MiB, WS_WIN = 4 * MiB, WS_WOUT = 14 * MiB, WS_XB = 18 * MiB, WS_PROJ = 50 * MiB, WS_END = 210 * MiB;
constexpr int LDS_BYTES = 147456;
constexpr int RS = 528;
constexpr int TILE_A = 0, TILE_B = 128 * RS, SM_OFF = 256 * RS;
static_assert(SM_OFF + 8192 <= LDS_BYTES, "LDS map");
constexpr int S_LF = 0, S_IG = 128, S_B = 256, S_COL = 384, S_A = 512, S_W = 640, S_ROWM = 768, S_INTER = 896, S_FLOOR = 1024, S_SC = 1152;

__device__ __forceinline__ float bflo(unsigned u) { return __uint_as_float(u << 16); }
__device__ __forceinline__ float bfhi(unsigned u) { return __uint_as_float(u & 0xffff0000u); }
__device__ __forceinline__ f32x4 cvt4(u32x2 v) { return (f32x4){bflo(v.x), bfhi(v.x), bflo(v.y), bfhi(v.y)}; }
__device__ __forceinline__ unsigned pk2(float lo, float hi) { return pg8::cvt_pk_bf16(lo, hi); }
__device__ __forceinline__ u32x2 pack4(f32x4 v) { u32x2 r; r.x = pk2(v[0], v[1]); r.y = pk2(v[2], v[3]); return r; }
__device__ __forceinline__ float rcpf(float x) { return __builtin_amdgcn_rcpf(x); }
__device__ __forceinline__ float silu_f(float z) { return z * rcpf(1.f + __expf(-z)); }
__device__ __forceinline__ float sigm_f(float z) { return rcpf(1.f + __expf(-z)); }
__device__ __forceinline__ f32x4 silu4(f32x4 z) { return (f32x4){silu_f(z[0]), silu_f(z[1]), silu_f(z[2]), silu_f(z[3])}; }

struct Args { const float* in[16]; float* out; unsigned char* ws; int ph_lo, ph_hi; };
enum { I_X = 0, I_NORMW, I_WIN, I_POOLW, I_POOLS, I_CONVW, I_CONVB, I_WQ, I_WK, I_WV, I_WIF, I_BIF, I_MHNW, I_MSKIP, I_WOUT, I_FNW };

__device__ __forceinline__ void p0_transpose_item(const float* W, int ldw, int src_c0, bf16* WT, int K, int dst_r0, const float* kscale, float* scr, int kb, int nb, int lane) {
    const int k0 = 64 * kb, n0 = 32 * nb;
#pragma unroll 8
    for (int i = 0; i < 32; ++i) { const int kk = 2 * i + (lane >> 5); float v = W[(size_t)(k0 + kk) * ldw + src_c0 + n0 + (lane & 31)]; if (kscale) v *= kscale[k0 + kk]; scr[kk * 33 + (lane & 31)] = v; }
    asm volatile("s_waitcnt lgkmcnt(0)" ::: "memory");
    const int c = lane & 7;
#pragma unroll
    for (int j = 0; j < 4; ++j) { const int n = (lane >> 3) + 8 * j; const float* s = scr + (8 * c) * 33 + n;
        u32x4 o; o.x = pk2(s[0 * 33], s[1 * 33]); o.y = pk2(s[2 * 33], s[3 * 33]); o.z = pk2(s[4 * 33], s[5 * 33]); o.w = pk2(s[6 * 33], s[7 * 33]);
        *(u32x4*)(WT + (size_t)(dst_r0 + n0 + n) * K + k0 + 8 * c) = o; }
    asm volatile("s_waitcnt lgkmcnt(0)" ::: "memory");
}

__device__ __forceinline__ void p0_prologue(const Args& a, unsigned char* lds, int tid, int lane, int wave) {
    const int G = gridDim.x, bid = blockIdx.x;
    unsigned char* ws = a.ws;
    bf16* WtIn = (bf16*)(ws + WS_WIN); bf16* WtOut = (bf16*)(ws + WS_WOUT); bf16* XB = (bf16*)(ws + WS_XB);
    const float* w_in = a.in[I_WIN]; const float* norm_w = a.in[I_NORMW];
    {
        float* As = (float*)lds;
        float* Bs = As + 64 * 33;
        const float* pool_w = a.in[I_POOLW];
        for (int it = bid; it < 256; it += G) {
            const int g = it >> 6, kb = (it >> 2) & 15, db = it & 3, k0 = kb * 64, d0 = db * 64;
            const int dd = tid & 63, kq = tid >> 6;
            float acc[8];
#pragma unroll
            for (int i = 0; i < 8; ++i) acc[i] = 0.f;
            for (int c0 = 0; c0 < 256; c0 += 32) {
                __syncthreads();
#pragma unroll
                for (int i = 0; i < 4; ++i) { const int idx = tid + 512 * i; { const int kk = idx >> 5, cc = idx & 31; As[kk * 33 + cc] = w_in[(size_t)(k0 + kk) * NIN + g * 256 + c0 + cc]; }
                    { const int cc = idx >> 6, d2 = idx & 63; Bs[cc * 65 + d2] = pool_w[((size_t)g * 256 + c0 + cc) * 256 + d0 + d2]; } }
                __syncthreads();
#pragma unroll 8
                for (int cc = 0; cc < 32; ++cc) { const float b = Bs[cc * 65 + dd];
#pragma unroll
                    for (int i = 0; i < 8; ++i) acc[i] += As[(kq * 8 + i) * 33 + cc] * b; }
            }
            const f32x4 s0 = *(const f32x4*)(norm_w + k0 + kq * 8), s1 = *(const f32x4*)(norm_w + k0 + kq * 8 + 4);
            u32x4 o; o.x = pk2(acc[0] * s0[0], acc[1] * s0[1]); o.y = pk2(acc[2] * s0[2], acc[3] * s0[3]); o.z = pk2(acc[4] * s1[0], acc[5] * s1[1]); o.w = pk2(acc[6] * s1[2], acc[7] * s1[3]);
            *(u32x4*)(WtIn + (size_t)(g * 256 + d0 + dd) * DM + k0 + kq * 8) = o;
        }
        __syncthreads();
    }
    {
        float* scr = (float*)(lds + wave * 16384);
        const int gw = bid * NWAVES + wave, NGW = G * NWAVES;
        constexpr int I_SEG = (DM / 64) * (1024 / 32);
        constexpr int I_O = (2048 / 64) * (DM / 32);
        for (int it = gw; it < 4 * I_SEG + I_O; it += NGW) {
            if (it < 4 * I_SEG) { const int seg = it / I_SEG, r = it % I_SEG, kb = r / 32, nb = r % 32;
                const int src = seg == 0 ? 2048 : seg == 1 ? 1024 : seg == 2 ? 3072 : 4096;
                const int dst = seg == 0 ? C_MX : seg == 1 ? C_PZ : seg == 2 ? C_MZ : C_MO;
                p0_transpose_item(w_in, NIN, src, WtIn, DM, dst, norm_w, scr, kb, nb, lane);
            } else { const int r = it - 4 * I_SEG, kb = r / 32, nb = r % 32; p0_transpose_item(a.in[I_WOUT], DM, 0, WtOut, 2048, 0, nullptr, scr, kb, nb, lane); }
        }
    }
    {
        float* Gxc = (float*)(ws + WS_GXC); float* Gmx = (float*)(ws + WS_GMX);
        const float* wq = a.in[I_WQ]; const float* wk = a.in[I_WK]; const float* wv = a.in[I_WV]; const float* wif = a.in[I_WIF];
        for (int idx = bid * NTHR + tid; idx < 1024 * 8; idx += G * NTHR) { const int i = idx >> 3, j = idx & 7, n = i >> 2, c = i & 3;
            float sx = 0.f, sm = 0.f;
#pragma unroll
            for (int d = 0; d < 4; ++d) { sx += wq[n * 16 + c * 4 + d] * wif[(n * 4 + d) * 8 + j] + wk[n * 16 + c * 4 + d] * wif[(1024 + n * 4 + d) * 8 + j]; sm += wv[n * 16 + c * 4 + d] * wif[(2048 + n * 4 + d) * 8 + j]; }
            Gxc[idx] = sx; Gmx[idx] = sm; }
    }
    {
        const float* x = a.in[I_X]; float* rstd = (float*)(ws + WS_RSTD);
        const int gw = bid * NWAVES + wave, NGW = G * NWAVES;
        for (int m = gw; m < T; m += NGW) {
            const f32x4* xr = (const f32x4*)(x + (size_t)m * DM) + lane; f32x4 v[4]; float s = 0.f;
#pragma unroll
            for (int j = 0; j < 4; ++j) { v[j] = xr[64 * j]; s += (v[j][0] * v[j][0] + v[j][1] * v[j][1]) + (v[j][2] * v[j][2] + v[j][3] * v[j][3]); }
#pragma unroll
            for (int o = 1; o < 64; o <<= 1) s += __shfl_xor(s, o);
            if (lane == 0) rstd[m] = 1.0f / sqrtf(s * (1.f / DM) + EPS);
            u32x2* o8 = (u32x2*)(XB + (size_t)m * DM) + lane;
#pragma unroll
            for (int j = 0; j < 4; ++j) o8[64 * j] = pack4(v[j]);
        }
    }
}

template <int WIN>
__device__ __forceinline__ void pool_strip(bf16* PROJ, int t0, int g, int lane, const float* pool_scale) {
    const int c = g * 256 + 4 * lane;
    const bf16* py = PROJ + C_PY + c; bf16* pz = PROJ + C_PZ + c;
    const f32x4 sc = *(const f32x4*)(pool_scale + c);
    const int p0 = t0 & (SEQ - 1);
    f32x4 S = (f32x4){0.f, 0.f, 0.f, 0.f};
    if (p0) {
#pragma unroll
        for (int j = 1; j <= WIN; ++j) S += cvt4(*(const u32x2*)(py + (size_t)(t0 - j) * LDP));
    }
    const float rw = 1.0f / WIN;
#pragma unroll 1
    for (int tb = 0; tb < 8; ++tb) {
        u32x2 cur[8], old[8], zz[8];
#pragma unroll
        for (int i = 0; i < 8; ++i) { const int pr = p0 + tb * 8 + i; const size_t ro = (size_t)(t0 + tb * 8 + i) * LDP; cur[i] = *(const u32x2*)(py + ro); zz[i] = *(const u32x2*)(pz + ro);
            old[i] = (u32x2){0u, 0u}; if (pr >= WIN) old[i] = *(const u32x2*)(py + ro - (size_t)WIN * LDP); }
#pragma unroll
        for (int i = 0; i < 8; ++i) {
            const f32x4 u = cvt4(cur[i]);
            S += u - cvt4(old[i]);
            const int pos = p0 + tb * 8 + i + 1; const float rc = pos >= WIN ? rw : 1.0f / (float)pos;
            const f32x4 d = S * rc - u; const f32x4 y = d * sc * silu4(cvt4(zz[i]));
            *(u32x2*)(pz + (size_t)(t0 + tb * 8 + i) * LDP) = pack4(y);
        }
    }
}

__device__ __forceinline__ void mlstm_strip(const bf16* PROJ, bf16* XC, int t0, int h, int lane, const float* conv_w, const float* conv_b, const float* Gxc, const float* Gmx, float* gp) {
    const int c = h * 256 + 4 * lane;
    f32x4 cw[4];
#pragma unroll
    for (int j = 0; j < 4; ++j) cw[j] = *(const f32x4*)(conv_w + j * 1024 + c);
    const f32x4 cb = *(const f32x4*)(conv_b + c);
    f32x4 gx[4][2], gm[4][2];
#pragma unroll
    for (int cc = 0; cc < 4; ++cc) { gx[cc][0] = *(const f32x4*)(Gxc + (c + cc) * 8); gx[cc][1] = *(const f32x4*)(Gxc + (c + cc) * 8 + 4); gm[cc][0] = *(const f32x4*)(Gmx + (c + cc) * 8); gm[cc][1] = *(const f32x4*)(Gmx + (c + cc) * 8 + 4); }
    const bf16* mx = PROJ + C_MX + c;
    const int p0 = t0 & (SEQ - 1);
    f32x4 m1 = (f32x4){0.f, 0.f, 0.f, 0.f}, m2 = m1, m3 = m1;
    if (p0) { m1 = cvt4(*(const u32x2*)(mx + (size_t)(t0 - 1) * LDP)); m2 = cvt4(*(const u32x2*)(mx + (size_t)(t0 - 2) * LDP)); m3 = cvt4(*(const u32x2*)(mx + (size_t)(t0 - 3) * LDP)); }
    const bool hi5 = lane & 32, hi4 = lane & 16, hi3 = lane & 8;
    const int jj = (hi5 ? 4 : 0) + (hi4 ? 2 : 0) + (hi3 ? 1 : 0);
#pragma unroll 1
    for (int tb = 0; tb < 4; ++tb) {
        u32x2 cur[16];
#pragma unroll
        for (int i = 0; i < 16; ++i) cur[i] = *(const u32x2*)(mx + (size_t)(t0 + tb * 16 + i) * LDP);
#pragma unroll
        for (int i = 0; i < 16; ++i) {
            const f32x4 m0 = cvt4(cur[i]);
            const f32x4 cv = cb + cw[0] * m3 + cw[1] * m2 + cw[2] * m1 + cw[3] * m0;
            const f32x4 xc = silu4(cv);
            *(u32x2*)(XC + (size_t)(t0 + tb * 16 + i) * DM + c) = pack4(xc);
            f32x4 v0 = (f32x4){0.f, 0.f, 0.f, 0.f}, v1 = v0;
#pragma unroll
            for (int cc = 0; cc < 4; ++cc) { v0 += gx[cc][0] * xc[cc] + gm[cc][0] * m0[cc]; v1 += gx[cc][1] * xc[cc] + gm[cc][1] * m0[cc]; }
            f32x4 keep = hi5 ? v1 : v0, send = hi5 ? v0 : v1, r;
#pragma unroll
            for (int q = 0; q < 4; ++q) r[q] = keep[q] + __shfl_xor(send[q], 32);
            const float k0 = hi4 ? r[2] : r[0], k1 = hi4 ? r[3] : r[1], s0 = hi4 ? r[0] : r[2], s1 = hi4 ? r[1] : r[3];
            const float r0 = k0 + __shfl_xor(s0, 16), r1 = k1 + __shfl_xor(s1, 16);
            float z = (hi3 ? r1 : r0) + __shfl_xor(hi3 ? r0 : r1, 8);
            z += __shfl_xor(z, 4); z += __shfl_xor(z, 2); z += __shfl_xor(z, 1);
            if ((lane & 7) == 0) gp[(tb * 16 + i) * 8 + jj] = z;
            m3 = m2; m2 = m1; m1 = m0;
        }
    }
}

__device__ __forceinline__ void p2_tokenlocal(const Args& a, unsigned char* lds, int tid, int lane, int wave) {
    unsigned char* ws = a.ws; bf16* PROJ = (bf16*)(ws + WS_PROJ); bf16* XC = (bf16*)(ws + WS_XB);
    float* gates = (float*)(ws + WS_GATES); float* gpl = (float*)lds;
    for (int it = blockIdx.x; it < T / 64; it += gridDim.x) {
        const int t0 = it * 64;
        if (wave < 4) { switch (wave) { case 0: pool_strip<2>(PROJ, t0, 0, lane, a.in[I_POOLS]); break; case 1: pool_strip<4>(PROJ, t0, 1, lane, a.in[I_POOLS]); break;
                        case 2: pool_strip<8>(PROJ, t0, 2, lane, a.in[I_POOLS]); break; default: pool_strip<16>(PROJ, t0, 3, lane, a.in[I_POOLS]); break; } }
        else mlstm_strip(PROJ, XC, t0, wave - 4, lane, a.in[I_CONVW], a.in[I_CONVB], (const float*)(ws + WS_GXC), (const float*)(ws + WS_GMX), gpl + (wave - 4) * 512);
        __syncthreads();
        { const int j = tid & 7; gates[(size_t)t0 * 8 + tid] = a.in[I_BIF][j] + ((gpl[tid] + gpl[512 + tid]) + (gpl[1024 + tid] + gpl[1536 + tid])); }
        __syncthreads();
    }
}

__device__ __forceinline__ void gate_setup(float* sm, const float* gates, int t0, int h, int tid, float m_s, bool full) {
    float ig = 0.f;
    if (tid < 128) { const float f = gates[(size_t)(t0 + tid) * 8 + 4 + h]; ig = gates[(size_t)(t0 + tid) * 8 + h];
        sm[S_LF + tid] = fminf(f, 0.f) - log1pf(expf(-fabsf(f))); sm[S_IG + tid] = ig; }
    __syncthreads();
    if (tid < 128) { float b = 0.f; for (int j = 0; j <= tid; ++j) b += sm[S_LF + j]; sm[S_B + tid] = b; sm[S_COL + tid] = ig - b; }
    __syncthreads();
    const float g = sm[S_B + 127];
    if (tid < 128) sm[S_A + tid] = g - sm[S_B + tid] + ig;
    __syncthreads();
    if (tid < 64) { float v = fmaxf(sm[S_A + tid], sm[S_A + tid + 64]);
#pragma unroll
        for (int o = 32; o >= 1; o >>= 1) v = fmaxf(v, __shfl_xor(v, o));
        if (tid == 0) { sm[S_SC + 0] = g; sm[S_SC + 1] = v; } }
    if (full && tid < 128) { float pm = -INFINITY; for (int j = 0; j <= tid; ++j) pm = fmaxf(pm, sm[S_COL + j]);
        const float rowm = fmaxf(pm, m_s); sm[S_ROWM + tid] = rowm; sm[S_INTER + tid] = __expf(m_s - rowm); sm[S_FLOOR + tid] = __expf(-(sm[S_B + tid] + rowm)); }
    __syncthreads();
    if (tid < 128) sm[S_W + tid] = __expf(sm[S_A + tid] - sm[S_SC + 1]);
    __syncthreads();
}

__device__ __forceinline__ void stage_kv(unsigned char* lds, const bf16* XC, const bf16* PROJ, const float* wk, const float* wv, int t0, int h, int tid, const float* sw  ) {
    const int j8 = tid & 31, n0 = h * 64 + 2 * j8;
    f32x4 k_w[2][4], v_w[2][4];
#pragma unroll
    for (int b = 0; b < 2; ++b)
#pragma unroll
        for (int c = 0; c < 4; ++c) { k_w[b][c] = *(const f32x4*)(wk + (n0 + b) * 16 + c * 4) * 0.0625f; v_w[b][c] = *(const f32x4*)(wv + (n0 + b) * 16 + c * 4); }
#pragma unroll 2
    for (int itk = 0; itk < 8; ++itk) {
        const int l = (tid >> 5) + 16 * itk;
        const u32x4 xr = *(const u32x4*)(XC + (size_t)(t0 + l) * DM + h * 256 + 8 * j8);
        const u32x4 mr = *(const u32x4*)(PROJ + (size_t)(t0 + l) * LDP + C_MX + h * 256 + 8 * j8);
        const float wl = sw ? sw[l] : 1.0f;
        const float xf[8] = {bflo(xr.x), bfhi(xr.x), bflo(xr.y), bfhi(xr.y), bflo(xr.z), bfhi(xr.z), bflo(xr.w), bfhi(xr.w)};
        const float mf[8] = {bflo(mr.x), bfhi(mr.x), bflo(mr.y), bfhi(mr.y), bflo(mr.z), bfhi(mr.z), bflo(mr.w), bfhi(mr.w)};
        f32x4 ko[2], vo[2];
#pragma unroll
        for (int b = 0; b < 2; ++b) { ko[b] = k_w[b][0] * xf[4 * b] + k_w[b][1] * xf[4 * b + 1] + k_w[b][2] * xf[4 * b + 2] + k_w[b][3] * xf[4 * b + 3];
            vo[b] = (v_w[b][0] * mf[4 * b] + v_w[b][1] * mf[4 * b + 1] + v_w[b][2] * mf[4 * b + 2] + v_w[b][3] * mf[4 * b + 3]) * wl; }
        u32x4 kp, vp; kp.x = pk2(ko[0][0], ko[0][1]); kp.y = pk2(ko[0][2], ko[0][3]); kp.z = pk2(ko[1][0], ko[1][1]); kp.w = pk2(ko[1][2], ko[1][3]);
        vp.x = pk2(vo[0][0], vo[0][1]); vp.y = pk2(vo[0][2], vo[0][3]); vp.z = pk2(vo[1][0], vo[1][1]); vp.w = pk2(vo[1][2], vo[1][3]);
        *(u32x4*)(lds + TILE_A + l * RS + j8 * 16) = kp;
        *(u32x4*)(lds + TILE_B + l * RS + j8 * 16) = vp;
    }
}

#define TR_READ(dst, addr) asm volatile("ds_read_b64_tr_b16 %0, %1" : "=&v"(dst) : "v"(addr) : "memory")
__device__ __forceinline__ bf16x8 mk8(u32x2 lo, u32x2 hi) { u32x4 v; v.x = lo.x; v.y = lo.y; v.z = hi.x; v.w = hi.y; return __builtin_bit_cast(bf16x8, v); }

__device__ __forceinline__ void p3_kvlocal(const Args& a, unsigned char* lds, int tid, int lane, int wave) {
    unsigned char* ws = a.ws; const bf16* PROJ = (const bf16*)(ws + WS_PROJ); const bf16* XC = (const bf16*)(ws + WS_XB);
    const float* gates = (const float*)(ws + WS_GATES); bf16* KV = (bf16*)a.out;
    float* GC = (float*)(ws + WS_GC); float* AMAX = (float*)(ws + WS_AMAX); float* NLOC = (float*)(ws + WS_NLOC);
    float* sm = (float*)(lds + SM_OFF);
    const unsigned lbase = (unsigned)(size_t)lds;
    const int kg = lane >> 4, q = (lane & 15) >> 2, p = lane & 3;
    for (int it = blockIdx.x; it < NITEM; it += gridDim.x) {
        const int b = it >> 8, h = (it >> 6) & 3, c = it & 63, t0 = b * SEQ + c * CHK;
        gate_setup(sm, gates, t0, h, tid, 0.f, false);
        stage_kv(lds, XC, PROJ, a.in[I_WK], a.in[I_WV], t0, h, tid, sm + S_W);
        __syncthreads();
        if (tid == 0) { GC[it] = sm[S_SC + 0]; AMAX[it] = sm[S_SC + 1]; }
        if (tid < 256) { float s = 0.f; for (int l = 0; l < CHK; ++l) s += sm[S_W + l] * __uint_as_float((unsigned)(*(const bf16*)(lds + TILE_A + l * RS + tid * 2)) << 16); NLOC[(size_t)it * 256 + tid] = s; }
        f32x4 acc[2][16];
#pragma unroll
        for (int j = 0; j < 2; ++j)
#pragma unroll
            for (int d = 0; d < 16; ++d) acc[j][d] = (f32x4){0.f, 0.f, 0.f, 0.f};
        const unsigned kaddr = lbase + TILE_A + (8 * kg + q) * RS + 8 * p;
        const unsigned vaddr = lbase + TILE_B + (8 * kg + q) * RS + 8 * p + wave * 64;
#pragma unroll 1
        for (int ks = 0; ks < 4; ++ks) {
            u32x2 bl[2][2];
#pragma unroll
            for (int j = 0; j < 2; ++j)
#pragma unroll
                for (int t = 0; t < 2; ++t) TR_READ(bl[j][t], vaddr + (32 * ks + 4 * t) * RS + j * 32);
#pragma unroll
            for (int d4 = 0; d4 < 4; ++d4) {
                u32x2 al[4][2];
#pragma unroll
                for (int i = 0; i < 4; ++i)
#pragma unroll
                    for (int t = 0; t < 2; ++t) TR_READ(al[i][t], kaddr + (32 * ks + 4 * t) * RS + (d4 * 4 + i) * 32);
                asm volatile("s_waitcnt lgkmcnt(0)" : "+v"(al[0][0]), "+v"(al[0][1]), "+v"(al[1][0]), "+v"(al[1][1]), "+v"(al[2][0]), "+v"(al[2][1]), "+v"(al[3][0]), "+v"(al[3][1]),
                             "+v"(bl[0][0]), "+v"(bl[0][1]), "+v"(bl[1][0]), "+v"(bl[1][1]) :: "memory");
#pragma unroll
                for (int i = 0; i < 4; ++i)
#pragma unroll
                    for (int j = 0; j < 2; ++j) acc[j][d4 * 4 + i] = __builtin_amdgcn_mfma_f32_16x16x32_bf16(mk8(al[i][0], al[i][1]), mk8(bl[j][0], bl[j][1]), acc[j][d4 * 4 + i], 0, 0, 0);
            }
        }
        bf16* kvo = KV + (size_t)it * 65536;
#pragma unroll
        for (int j = 0; j < 2; ++j) { const int e = wave * 32 + j * 16 + (lane & 15);
#pragma unroll
            for (int d = 0; d < 16; ++d) *(u32x2*)(kvo + e * 256 + d * 16 + 4 * kg) = pack4(acc[j][d]); }
        __syncthreads();
    }
}

__device__ __forceinline__ void p4_scan(const Args& a, int tid) {
    unsigned char* ws = a.ws; bf16* KV = (bf16*)a.out;
    const float* GC = (const float*)(ws + WS_GC); const float* AMAX = (const float*)(ws + WS_AMAX); float* MS = (float*)(ws + WS_MS); float* NLOC = (float*)(ws + WS_NLOC);
    const int NT = gridDim.x * NTHR;
    for (int gt = blockIdx.x * NTHR + tid; gt < 8 * 16384; gt += NT) {
        const int bh = gt >> 14, off = (gt & 16383) * 4;
        f32x4 C = (f32x4){0.f, 0.f, 0.f, 0.f}; float m = 0.f;
        bf16* base = KV + (size_t)bh * 64 * 65536 + off;
#pragma unroll 1
        for (int cb = 0; cb < 64; cb += 16) {
            u32x2 kv[16];
#pragma unroll
            for (int i = 0; i < 16; ++i) kv[i] = *(const u32x2*)(base + (size_t)(cb + i) * 65536);
#pragma unroll
            for (int i = 0; i < 16; ++i) { const int item = bh * 64 + cb + i; const float g = GC[item], am = AMAX[item];
                if (off == 0) MS[item] = m;
                *(u32x2*)(base + (size_t)(cb + i) * 65536) = pack4(C);
                const float mn = fmaxf(g + m, am), dec = __expf(g + m - mn), scl = __expf(am - mn);
                C = C * dec + cvt4(kv[i]) * scl; m = mn; }
        }
    }
    for (int gt = blockIdx.x * NTHR + tid; gt < 8 * 256; gt += NT) {
        const int bh = gt >> 8, d = gt & 255; float n = 0.f, m = 0.f;
        for (int c = 0; c < 64; ++c) { const int item = bh * 64 + c; const float g = GC[item], am = AMAX[item]; const float nl = NLOC[(size_t)item * 256 + d];
            NLOC[(size_t)item * 256 + d] = n;
            const float mn = fmaxf(g + m, am); n = n * __expf(g + m - mn) + nl * __expf(am - mn); m = mn; }
    }
}

__device__ __forceinline__ void p5_mlstm_out(const Args& a, unsigned char* lds, int tid, int lane, int wave) {
    unsigned char* ws = a.ws; bf16* PROJ = (bf16*)(ws + WS_PROJ); const bf16* XC = (const bf16*)(ws + WS_XB);
    const float* gates = (const float*)(ws + WS_GATES); const bf16* KV = (const bf16*)a.out;
    const float* MS = (const float*)(ws + WS_MS); const float* NS = (const float*)(ws + WS_NLOC);
    const float* wq = a.in[I_WQ];
    float* sm = (float*)(lds + SM_OFF);
    const unsigned lbase = (unsigned)(size_t)lds;
    const int kg = lane >> 4, li = lane & 15, q = li >> 2, p = lane & 3;
    for (int it = blockIdx.x; it < NITEM; it += gridDim.x) {
        const int b = it >> 8, h = (it >> 6) & 3, c = it & 63, t0 = b * SEQ + c * CHK;
        const float m_s = MS[it];
        gate_setup(sm, gates, t0, h, tid, m_s, true);
        stage_kv(lds, XC, PROJ, a.in[I_WK], a.in[I_WV], t0, h, tid, nullptr);
        const int l = wave * 16 + li; const size_t trow = (size_t)(t0 + l);
        bf16x8 qf[8]; float nq = 0.f;
#pragma unroll
        for (int ks = 0; ks < 8; ++ks) {
            const int ch0 = h * 256 + 32 * ks + 8 * kg; const u32x4 xr = *(const u32x4*)(XC + trow * DM + ch0);
            const float xf[8] = {bflo(xr.x), bfhi(xr.x), bflo(xr.y), bfhi(xr.y), bflo(xr.z), bfhi(xr.z), bflo(xr.w), bfhi(xr.w)};
            f32x4 qo[2];
#pragma unroll
            for (int bb = 0; bb < 2; ++bb) { const float* w = wq + (size_t)((ch0 >> 2) + bb) * 16;
                qo[bb] = *(const f32x4*)(w) * xf[4 * bb] + *(const f32x4*)(w + 4) * xf[4 * bb + 1] + *(const f32x4*)(w + 8) * xf[4 * bb + 2] + *(const f32x4*)(w + 12) * xf[4 * bb + 3]; }
            const f32x4 n0 = *(const f32x4*)(NS + (size_t)it * 256 + 32 * ks + 8 * kg), n1 = *(const f32x4*)(NS + (size_t)it * 256 + 32 * ks + 8 * kg + 4);
            nq += (qo[0][0] * n0[0] + qo[0][1] * n0[1]) + (qo[0][2] * n0[2] + qo[0][3] * n0[3]) + (qo[1][0] * n1[0] + qo[1][1] * n1[1]) + (qo[1][2] * n1[2] + qo[1][3] * n1[3]);
            u32x4 pk; pk.x = pk2(qo[0][0], qo[0][1]); pk.y = pk2(qo[0][2], qo[0][3]); pk.z = pk2(qo[1][0], qo[1][1]); pk.w = pk2(qo[1][2], qo[1][3]);
            qf[ks] = __builtin_bit_cast(bf16x8, pk);
            asm volatile("" ::: "memory");
        }
        nq += __shfl_xor(nq, 16); nq += __shfl_xor(nq, 32);
        __syncthreads();
        const float rowm = sm[S_ROWM + l], inter = sm[S_INTER + l], flr = sm[S_FLOOR + l];
        f32x4 acc[16];
#pragma unroll
        for (int et = 0; et < 16; ++et) acc[et] = (f32x4){0.f, 0.f, 0.f, 0.f};
        float rowsum = 0.f;
        const unsigned vaddr = lbase + TILE_B + (4 * kg + q) * RS + 8 * p;
        const int ntp = (wave >> 1) + 1;
#pragma unroll 1
        for (int tp = 0; tp < ntp; ++tp) {
            f32x4 S0 = (f32x4){0.f, 0.f, 0.f, 0.f}, S1 = S0;
#pragma unroll
            for (int ks = 0; ks < 8; ++ks) { const bf16x8 a0 = *(const bf16x8*)(lds + TILE_A + (32 * tp + li) * RS + (32 * ks + 8 * kg) * 2); const bf16x8 a1 = *(const bf16x8*)(lds + TILE_A + (32 * tp + 16 + li) * RS + (32 * ks + 8 * kg) * 2);
                S0 = __builtin_amdgcn_mfma_f32_16x16x32_bf16(a0, qf[ks], S0, 0, 0, 0); S1 = __builtin_amdgcn_mfma_f32_16x16x32_bf16(a1, qf[ks], S1, 0, 0, 0); }
            const int s0 = 32 * tp + 4 * kg;
            const f32x4 c0 = *(const f32x4*)(sm + S_COL + s0), c1 = *(const f32x4*)(sm + S_COL + s0 + 16);
            f32x4 w0, w1;
#pragma unroll
            for (int r = 0; r < 4; ++r) { w0[r] = (s0 + r <= l) ? S0[r] * __expf(c0[r] - rowm) : 0.f; w1[r] = (s0 + 16 + r <= l) ? S1[r] * __expf(c1[r] - rowm) : 0.f; }
            rowsum += (w0[0] + w0[1]) + (w0[2] + w0[3]) + (w1[0] + w1[1]) + (w1[2] + w1[3]);
            u32x4 pp; pp.x = pk2(w0[0], w0[1]); pp.y = pk2(w0[2], w0[3]); pp.z = pk2(w1[0], w1[1]); pp.w = pk2(w1[2], w1[3]);
            const bf16x8 pf = __builtin_bit_cast(bf16x8, pp);
            const unsigned va = vaddr + (32 * tp) * RS;
#pragma unroll
            for (int e4 = 0; e4 < 4; ++e4) {
                u32x2 vl[4][2];
#pragma unroll
                for (int i = 0; i < 4; ++i) { TR_READ(vl[i][0], va + (e4 * 4 + i) * 32); TR_READ(vl[i][1], va + 16 * RS + (e4 * 4 + i) * 32); }
                asm volatile("s_waitcnt lgkmcnt(0)" : "+v"(vl[0][0]), "+v"(vl[0][1]), "+v"(vl[1][0]), "+v"(vl[1][1]), "+v"(vl[2][0]), "+v"(vl[2][1]), "+v"(vl[3][0]), "+v"(vl[3][1]) :: "memory");
#pragma unroll
                for (int i = 0; i < 4; ++i) acc[e4 * 4 + i] = __builtin_amdgcn_mfma_f32_16x16x32_bf16(mk8(vl[i][0], vl[i][1]), pf, acc[e4 * 4 + i], 0, 0, 0);
            }
        }
#pragma unroll
        for (int ks = 0; ks < 8; ++ks) { const u32x4 v = __builtin_bit_cast(u32x4, qf[ks]); u32x4 o;
            o.x = pk2(bflo(v.x) * inter, bfhi(v.x) * inter); o.y = pk2(bflo(v.y) * inter, bfhi(v.y) * inter); o.z = pk2(bflo(v.z) * inter, bfhi(v.z) * inter); o.w = pk2(bflo(v.w) * inter, bfhi(v.w) * inter);
            qf[ks] = __builtin_bit_cast(bf16x8, o); }
        __syncthreads();
        { const bf16* src = KV + (size_t)it * 65536;
#pragma unroll 4
          for (int i = 0; i < 16; ++i) { const int idx = tid + 512 * i, e = idx >> 5, ch = idx & 31; *(u32x4*)(lds + e * RS + ch * 16) = *(const u32x4*)(src + e * 256 + ch * 8); } }
        __syncthreads();
#pragma unroll
        for (int et = 0; et < 16; ++et) {
#pragma unroll
            for (int ks = 0; ks < 8; ++ks) { const bf16x8 af = *(const bf16x8*)(lds + (16 * et + li) * RS + (32 * ks + 8 * kg) * 2); acc[et] = __builtin_amdgcn_mfma_f32_16x16x32_bf16(af, qf[ks], acc[et], 0, 0, 0); }
            asm volatile("" ::: "memory");
        }
        rowsum += __shfl_xor(rowsum, 16); rowsum += __shfl_xor(rowsum, 32);
        const float den = rowsum + inter * nq; const float rinv = 1.0f / fmaxf(fabsf(den), flr);
        bf16* prow = PROJ + trow * LDP + h * 256 + 4 * kg;
        float sum = 0.f;
#pragma unroll
        for (int et = 0; et < 16; ++et) { const f32x4 mo = cvt4(*(const u32x2*)(prow + C_MO + 16 * et));
#pragma unroll
            for (int r = 0; r < 4; ++r) { acc[et][r] = acc[et][r] * rinv * sigm_f(mo[r]); sum += acc[et][r]; }
            if ((et & 3) == 3) asm volatile("" ::: "memory"); }
        sum += __shfl_xor(sum, 16); sum += __shfl_xor(sum, 32);
        const float mu = sum * (1.0f / 256.0f); float vs = 0.f;
#pragma unroll
        for (int et = 0; et < 16; ++et)
#pragma unroll
            for (int r = 0; r < 4; ++r) { const float dlt = acc[et][r] - mu; vs += dlt * dlt; }
        vs += __shfl_xor(vs, 16); vs += __shfl_xor(vs, 32);
        const float rstd = 1.0f / sqrtf(vs * (1.0f / 256.0f) + EPS);
        const float* nw = a.in[I_MHNW] + h * 256 + 4 * kg; const float* sk = a.in[I_MSKIP] + h * 256 + 4 * kg;
        const bf16* xcr = XC + trow * DM + h * 256 + 4 * kg;
#pragma unroll
        for (int et = 0; et < 16; ++et) { const f32x4 mz = cvt4(*(const u32x2*)(prow + C_MZ + 16 * et)); const f32x4 xc = cvt4(*(const u32x2*)(xcr + 16 * et));
            const f32x4 w4 = *(const f32x4*)(nw + 16 * et), s4 = *(const f32x4*)(sk + 16 * et);
            const f32x4 y = ((acc[et] - mu) * rstd * w4 + s4 * xc) * silu4(mz);
            *(u32x2*)(prow + C_MZ + 16 * et) = pack4(y);
            if (et & 1) asm volatile("" ::: "memory"); }
        __syncthreads();
    }
}

__device__ __forceinline__ void p7_final_norm(const Args& a, int lane, int wave) {
    const float* fw = a.in[I_FNW]; float* y = a.out;
    const int gw = blockIdx.x * NWAVES + wave, NGW = gridDim.x * NWAVES;
    f32x4 w[4];
#pragma unroll
    for (int j = 0; j < 4; ++j) w[j] = ((const f32x4*)fw)[lane + 64 * j];
    for (int m = gw; m < T; m += NGW) {
        f32x4* yr = (f32x4*)(y + (size_t)m * DM) + lane; f32x4 v[4]; float s = 0.f;
#pragma unroll
        for (int j = 0; j < 4; ++j) { v[j] = yr[64 * j]; s += (v[j][0] * v[j][0] + v[j][1] * v[j][1]) + (v[j][2] * v[j][2] + v[j][3] * v[j][3]); }
#pragma unroll
        for (int o = 1; o < 64; o <<= 1) s += __shfl_xor(s, o);
        const float r = 1.0f / sqrtf(s * (1.f / DM) + EPS);
#pragma unroll
        for (int j = 0; j < 4; ++j) yr[64 * j] = v[j] * r * w[j];
    }
}

__global__ void __launch_bounds__(NTHR) fwd_megakernel(Args args) {
    extern __shared__ __attribute__((aligned(16))) unsigned char lds[];
    cg::grid_group grid = cg::this_grid();
    const int tid = threadIdx.x, lane = tid & 63, wave = __builtin_amdgcn_readfirstlane(tid >> 6);
    const int lo = args.ph_lo, hi = args.ph_hi;
    unsigned char* ws = args.ws;
#define IN(k) (lo <= (k) && (k) < hi)
#define SEAM(k) do { if (IN(k) && IN((k) + 1)) grid.sync(); } while (0)
    if (IN(0)) p0_prologue(args, lds, tid, lane, wave);
    SEAM(0);
    if (IN(1)) { pg8::Gemm g{(const bf16*)(ws + WS_XB), (const bf16*)(ws + WS_WIN), T, NIN, DM, DM, DM}; pg8::StaticOrder S; S.init(T, NIN, gridDim.x, blockIdx.x);
        pg8::EpiProj E{(bf16*)(ws + WS_PROJ), LDP, (const float*)(ws + WS_RSTD)};
        pg8::gemm_phase<pg8::EpiProj, pg8::StaticOrder>((PG8_LAS unsigned char*)lds, g, S, E); }
    SEAM(1);
    if (IN(2)) p2_tokenlocal(args, lds, tid, lane, wave);
    SEAM(2);
    if (IN(3)) p3_kvlocal(args, lds, tid, lane, wave);
    SEAM(3);
    if (IN(4)) p4_scan(args, tid);
    SEAM(4);
    if (IN(5)) p5_mlstm_out(args, lds, tid, lane, wave);
    SEAM(5);
    if (IN(6)) { pg8::Gemm g{(const bf16*)(ws + WS_PROJ) + C_PZ, (const bf16*)(ws + WS_WOUT), T, DM, 2048, LDP, 2048}; pg8::StaticOrder S; S.init(T, DM, gridDim.x, blockIdx.x);
        pg8::EpiResid E{args.in[I_X], args.out, DM};
        pg8::gemm_phase<pg8::EpiResid, pg8::StaticOrder>((PG8_LAS unsigned char*)lds, g, S, E); }
    SEAM(6);
    if (IN(7)) p7_final_norm(args, lane, wave);
#undef IN
#undef SEAM
}

extern "C" void kernel_launch(void* const* d_in, const int* in_sizes, int n_in, void* d_out, int out_size, void* d_ws, size_t ws_size, hipStream_t stream) {
    static int grid = 0;
    if (grid == 0) {
        if (n_in != 16 || in_sizes[0] != T * DM || out_size != T * DM || ws_size < WS_END) { fprintf(stderr, "kernel_launch: unexpected shapes (n_in %d, ws %zu)\n", n_in, ws_size); grid = -1; return; }
        int dev = 0, cus = 0, per_cu = 0;
        hipGetDevice(&dev); hipDeviceGetAttribute(&cus, hipDeviceAttributeMultiprocessorCount, dev);
        hipFuncSetAttribute((const void*)fwd_megakernel, hipFuncAttributeMaxDynamicSharedMemorySize, LDS_BYTES);
        if (hipOccupancyMaxActiveBlocksPerMultiprocessor(&per_cu, (const void*)fwd_megakernel, NTHR, LDS_BYTES) != hipSuccess || per_cu < 1) { fprintf(stderr, "kernel_launch: occupancy query says %d blocks/CU\n", per_cu); per_cu = 1; }
        (void)hipGetLastError();
        grid = cus * 1;
        if (grid <= 0) grid = 256;
    }
    if (grid < 0) return;
    Args a{};
    for (int i = 0; i < 16; ++i) a.in[i] = (const float*)d_in[i];
    a.out = (float*)d_out; a.ws = (unsigned char*)d_ws;
#if MK_MULTI
    for (int ph = 0; ph < 8; ++ph) { a.ph_lo = ph; a.ph_hi = ph + 1; hipLaunchKernelGGL(fwd_megakernel, dim3(grid), dim3(NTHR), LDS_BYTES, stream, a); }
#else
    a.ph_lo = 0; a.ph_hi = 8;
    void* kargs[] = {&a};
    hipError_t e = hipLaunchCooperativeKernel((const void*)fwd_megakernel, dim3(grid), dim3(NTHR), kargs, LDS_BYTES, stream);
    if (e != hipSuccess) fprintf(stderr, "cooperative launch failed: %s (grid %d)\n", hipGetErrorString(e), grid);
#endif
}
```

```cpp
#include <hip/hip_runtime.h>
#include <hip/hip_cooperative_groups.h>
#include <cstdio>
#include <cstdint>
namespace cg = cooperative_groups;

#ifndef PROBE_DUP
#define PROBE_DUP -1
#endif
#ifndef MK_MULTI
#define MK_MULTI 0
#endif

namespace pg8 {
#define PG8_LAS __attribute__((address_space(3)))
typedef unsigned short bf16_t;
typedef short bf16x8 __attribute__((ext_vector_type(8)));
typedef float f32x4 __attribute__((ext_vector_type(4)));
typedef unsigned u32x4 __attribute__((ext_vector_type(4)));
constexpr int BM = 256, BK = 64, HALF = 128, HTB = HALF * BK * 2, STAGE_BYTES = 8 * HTB, NXCD = 8, WGM = 8;

__host__ __device__ __forceinline__ int lds_byte(int r, int c) { const int st = (r >> 4) * 2 + (c >> 5), rr = r & 15, cc = c & 31, ob = rr * 64 + cc * 2; return st * 1024 + (ob ^ (((ob >> 9) & 1) << 5)); }
__host__ __device__ __forceinline__ void stage_rc(int b, int& R, int& C) { const int st = b / 1024, sb = b % 1024, swz = sb ^ (((sb >> 9) & 1) << 5); R = (st >> 1) * 16 + swz / 64; C = (st & 1) * 32 + (swz % 64) / 2; }
__host__ __device__ __forceinline__ int perm32(int rho) { const int n = rho >> 4, i = rho & 15; return 8 * (i >> 2) + 4 * n + (i & 3); }

struct Unit { int pm, pn; };
struct Gemm { const bf16_t* A; const bf16_t* Bt; int M, N, K, lda, ldb; };

struct StaticOrder {
    int nM, nN, nwg, G, c;
    __host__ __device__ void init(int M, int N, int G_, int c_) { nM = M / BM; nN = N / BM; nwg = nM * nN; G = G_; c = c_; }
    __host__ __device__ bool next(int i, Unit& u) const {
        const long L = (long)i * G + c; if (L >= nwg) return false;
        int wgid = (int)L; { const int q = nwg / NXCD, r = nwg % NXCD, xcd = wgid % NXCD, off = wgid / NXCD; wgid = (xcd < r ? xcd * (q + 1) : r * (q + 1) + (xcd - r) * q) + off; }
        const int nig = WGM * nN, gid = wgid / nig, fm = gid * WGM, gsz = (nM - fm) < WGM ? (nM - fm) : WGM;
        u.pm = fm + ((wgid % nig) % gsz); u.pn = (wgid % nig) / gsz; return true;
    }
};

__device__ __forceinline__ unsigned cvt_pk_bf16(float lo, float hi) { unsigned r; asm volatile("v_cvt_pk_bf16_f32 %0, %1, %2" : "=v"(r) : "v"(lo), "v"(hi)); return r; }

struct EpiProj {
    static constexpr bool PERM = true;
    bf16_t* O; int ldc; const float* rstd;
    __device__ __forceinline__ void operator()(const f32x4 (&acc)[2][2][4][2], const Unit& u, int wr, int wc, int fr, int fq) const {
        const int row0 = u.pm * BM + wr * 64 + fr; const int col0 = u.pn * BM + wc * 32 + 8 * fq;
#pragma unroll
        for (int ai = 0; ai < 2; ++ai)
#pragma unroll
            for (int m = 0; m < 4; ++m) { const int row = row0 + ai * HALF + m * 16; const float sc = rstd[row]; bf16_t* rowp = O + (size_t)row * ldc + col0;
#pragma unroll
                for (int bj = 0; bj < 2; ++bj) { f32x4 v0 = acc[ai][bj][m][0] * sc, v1 = acc[ai][bj][m][1] * sc;
                    u32x4 w; w.x = cvt_pk_bf16(v0[0], v0[1]); w.y = cvt_pk_bf16(v0[2], v0[3]); w.z = cvt_pk_bf16(v1[0], v1[1]); w.w = cvt_pk_bf16(v1[2], v1[3]);
                    *(u32x4*)(rowp + bj * HALF) = w; } }
    }
};
struct EpiResid {
    static constexpr bool PERM = false;
    const float* base; float* out; int ldc;
    __device__ __forceinline__ void operator()(const f32x4 (&acc)[2][2][4][2], const Unit& u, int wr, int wc, int fr, int fq) const {
        const int col0 = u.pn * BM + wc * 32 + 4 * fq;
#pragma unroll
        for (int ai = 0; ai < 2; ++ai)
#pragma unroll
            for (int m = 0; m < 4; ++m) { const size_t off = (size_t)(u.pm * BM + ai * HALF + wr * 64 + m * 16 + fr) * ldc + col0;
#pragma unroll
                for (int bj = 0; bj < 2; ++bj)
#pragma unroll
                    for (int n = 0; n < 2; ++n) { const f32x4 bs = *(const f32x4*)(base + off + bj * HALF + n * 16); *(f32x4*)(out + off + bj * HALF + n * 16) = bs + acc[ai][bj][m][n]; } }
    }
};

template <class Epi, class Sched>
__device__ __forceinline__ void gemm_phase(PG8_LAS unsigned char* lds, const Gemm g, const Sched& S, const Epi& E) {
    const int tid = threadIdx.x, wid = __builtin_amdgcn_readfirstlane(tid >> 6), lane = tid & 63, wr = wid >> 2, wc = wid & 3, fr = lane & 15, fq = lane >> 4;
    const int K = g.K, nt = K / BK;
    unsigned voffA[2], voffB[2];
#pragma unroll
    for (int i = 0; i < 2; ++i) { int R, C; stage_rc(tid * 16 + i * 8192, R, C); const int Rb = Epi::PERM ? ((R & ~31) + perm32(R & 31)) : R;
        voffA[i] = (unsigned)(R * g.lda + C) * 2u; voffB[i] = (unsigned)(Rb * g.ldb + C) * 2u; }
    const size_t kstep = (size_t)(BK * 2);
    const size_t hA = (size_t)HALF * g.lda * 2, hB = (size_t)HALF * g.ldb * 2;
    const size_t tA = 2 * hA, tB = 2 * hB;
    const unsigned ldsw = (unsigned)wid * 1024u;
    const int aoff = lds_byte(wr * 64 + fr, fq * 8), boff = lds_byte(wc * 32 + fr, fq * 8);
#define PG8_SA(b, h) (((b) * 2 + (h)) * HTB)
#define PG8_SB(b, h) ((4 + (b) * 2 + (h)) * HTB)
#define PG8_STAGE(bufoff, gbase, voff) do { _Pragma("unroll") for (int _i = 0; _i < 2; ++_i) \
        __builtin_amdgcn_global_load_lds((const unsigned*)((const char*)(gbase) + (voff)[_i]), (PG8_LAS unsigned*)(lds + (bufoff) + ldsw + _i * 8192), 16, 0, 0); } while (0)
#define PG8_LDA(dst, b, h) do { _Pragma("unroll") for (int m = 0; m < 4; ++m) _Pragma("unroll") for (int k = 0; k < 2; ++k) dst[m][k] = *(const PG8_LAS bf16x8*)(lds + PG8_SA(b, h) + aoff + m * 2048 + k * 1024); } while (0)
#define PG8_LDB(dst, b, h) do { _Pragma("unroll") for (int n = 0; n < 2; ++n) _Pragma("unroll") for (int k = 0; k < 2; ++k) dst[n][k] = *(const PG8_LAS bf16x8*)(lds + PG8_SB(b, h) + boff + n * 2048 + k * 1024); } while (0)
#define PG8_MMA(ai, bj, At, Bt) do { __builtin_amdgcn_s_setprio(1); _Pragma("unroll") for (int m = 0; m < 4; ++m) _Pragma("unroll") for (int n = 0; n < 2; ++n) _Pragma("unroll") for (int k = 0; k < 2; ++k) \
        acc[ai][bj][m][n] = __builtin_amdgcn_mfma_f32_16x16x32_bf16(Bt[n][k], At[m][k], acc[ai][bj][m][n], 0, 0, 0); __builtin_amdgcn_s_setprio(0); } while (0)
#define PG8_WAIT_V(n) asm volatile("s_waitcnt vmcnt(" #n ")" ::: "memory")
#define PG8_WAIT_L(n) asm volatile("s_waitcnt lgkmcnt(" #n ")" ::: "memory")
#define PG8_BAR __builtin_amdgcn_s_barrier()
#define PG8_SCHED __builtin_amdgcn_sched_barrier(0)
    Unit cur, nxt; int ui = 0;
    if (!S.next(0, cur)) return;
    f32x4 acc[2][2][4][2];
#pragma unroll
    for (int a = 0; a < 2; ++a)
#pragma unroll
        for (int b = 0; b < 2; ++b)
#pragma unroll
            for (int m = 0; m < 4; ++m)
#pragma unroll
                for (int n = 0; n < 2; ++n) acc[a][b][m][n] = (f32x4){0.f, 0.f, 0.f, 0.f};
    bf16x8 At[4][2], B0[2][2], B1[2][2];
    const char* cA = (const char*)g.A + (size_t)cur.pm * tA; const char* cB = (const char*)g.Bt + (size_t)cur.pn * tB;
    PG8_STAGE(PG8_SB(0, 0), cB, voffB); PG8_STAGE(PG8_SB(0, 1), cB + hB, voffB); PG8_STAGE(PG8_SA(0, 0), cA, voffA); PG8_STAGE(PG8_SA(0, 1), cA + hA, voffA);
    if (wr == 1) PG8_BAR;
    PG8_WAIT_V(2); PG8_BAR;
    PG8_STAGE(PG8_SB(1, 0), cB + kstep, voffB); PG8_STAGE(PG8_SA(1, 0), cA + kstep, voffA); PG8_STAGE(PG8_SB(1, 1), cB + hB + kstep, voffB);
    PG8_WAIT_V(6); PG8_BAR;
    for (;;) {
        const bool has_next = S.next(ui + 1, nxt);
        const char* nA = has_next ? (const char*)g.A + (size_t)nxt.pm * tA : cA; const char* nB = has_next ? (const char*)g.Bt + (size_t)nxt.pn * tB : cB;
        for (int t = 0; t < nt; t += 2) {
            const bool last = (t == nt - 2);
            const char* a1 = cA + (size_t)(t + 1) * kstep;
            const char* a2 = last ? nA : cA + (size_t)(t + 2) * kstep; const char* b2 = last ? nB : cB + (size_t)(t + 2) * kstep;
            const char* a3 = a2 + kstep; const char* b3 = b2 + kstep;
            PG8_LDB(B0, 0, 0); PG8_LDB(B1, 0, 1); PG8_SCHED; PG8_LDA(At, 0, 0); PG8_STAGE(PG8_SA(1, 1), a1 + hA, voffA);
            PG8_WAIT_V(8); PG8_WAIT_L(0); PG8_BAR; PG8_MMA(0, 0, At, B0); PG8_MMA(0, 1, At, B1); PG8_BAR; PG8_SCHED;
            PG8_LDA(At, 0, 1); PG8_STAGE(PG8_SB(0, 0), b2, voffB); PG8_STAGE(PG8_SB(0, 1), b2 + hB, voffB); PG8_STAGE(PG8_SA(0, 0), a2, voffA);
            PG8_WAIT_V(8); PG8_WAIT_L(0); PG8_BAR; PG8_MMA(1, 0, At, B0); PG8_MMA(1, 1, At, B1); PG8_BAR; PG8_SCHED;
            PG8_LDB(B0, 1, 0); PG8_LDB(B1, 1, 1); PG8_SCHED; PG8_LDA(At, 1, 0); PG8_STAGE(PG8_SA(0, 1), a2 + hA, voffA);
            PG8_WAIT_V(8); PG8_WAIT_L(0); PG8_BAR; PG8_MMA(0, 0, At, B0); PG8_MMA(0, 1, At, B1); PG8_BAR; PG8_SCHED;
            PG8_LDA(At, 1, 1); PG8_STAGE(PG8_SB(1, 0), b3, voffB); PG8_STAGE(PG8_SB(1, 1), b3 + hB, voffB); PG8_STAGE(PG8_SA(1, 0), a3, voffA);
            PG8_WAIT_V(8); PG8_WAIT_L(0); PG8_BAR; PG8_MMA(1, 0, At, B0); PG8_MMA(1, 1, At, B1); PG8_BAR; PG8_SCHED;
        }
        if (wr == 0) PG8_BAR;
        E(acc, cur, wr, wc, fr, fq);
        if (!has_next) break;
#pragma unroll
        for (int a = 0; a < 2; ++a)
#pragma unroll
            for (int b = 0; b < 2; ++b)
#pragma unroll
                for (int m = 0; m < 4; ++m)
#pragma unroll
                    for (int n = 0; n < 2; ++n) acc[a][b][m][n] = (f32x4){0.f, 0.f, 0.f, 0.f};
        cur = nxt; cA = nA; cB = nB; ++ui;
        if (wr == 1) PG8_BAR;
    }
    PG8_WAIT_V(0);
    PG8_BAR;
#undef PG8_SA
#undef PG8_SB
#undef PG8_STAGE
#undef PG8_LDA
#undef PG8_LDB
#undef PG8_MMA
#undef PG8_WAIT_V
#undef PG8_WAIT_L
#undef PG8_BAR
#undef PG8_SCHED
}
}

typedef unsigned short bf16;
typedef short bf16x8 __attribute__((ext_vector_type(8)));
typedef float f32x4 __attribute__((ext_vector_type(4)));
typedef unsigned u32x4 __attribute__((ext_vector_type(4)));
typedef unsigned u32x2 __attribute__((ext_vector_type(2)));

constexpr int NWAVES = 8, NTHR = 512;
constexpr int SEQ = 8192, NB = 2, T = NB * SEQ, DM = 1024, NIN = 5120, LDP = NIN;
constexpr int NH = 4, DH = 256, CHK = 128, NCH = SEQ / CHK, NITEM = NB * NH * NCH;
constexpr int C_PY = 0, C_MX = 1024, C_PZ = 2048, C_MZ = 3072, C_MO = 4096;
constexpr float EPS = 1e-6f;
constexpr size_t MiB = 1u << 20;
constexpr size_t WS_BAR = 131072, BAR_BYTES = 16384;
constexpr size_t WS_GXC = 0, WS_GMX = 32768, WS_GC = 65536, WS_AMAX = 65536 + 4096, WS_MS = 65536 + 8192;
constexpr size_t WS_RSTD = 1 * MiB, WS_GATES = 2 * MiB, WS_NLOC = 3 * MiB, WS_WIN = 4 * MiB, WS_WOUT = 14 * MiB, WS_XB = 18 * MiB, WS_PROJ = 50 * MiB, WS_END = 210 * MiB;
constexpr int LDS_BYTES = 147456, LDS_BARST = LDS_BYTES - 64;
constexpr int RS = 528;
constexpr int TILE_A = 0, TILE_B = 128 * RS, SM_OFF = 256 * RS;
static_assert(SM_OFF + 8192 <= LDS_BYTES, "LDS map");
constexpr int S_LF = 0, S_IG = 128, S_B = 256, S_COL = 384, S_A = 512, S_W = 640, S_ROWM = 768, S_INTER = 896, S_FLOOR = 1024, S_SC = 1152;

__device__ __forceinline__ float bflo(unsigned u) { return __uint_as_float(u << 16); }
__device__ __forceinline__ float bfhi(unsigned u) { return __uint_as_float(u & 0xffff0000u); }
__device__ __forceinline__ f32x4 cvt4(u32x2 v) { return (f32x4){bflo(v.x), bfhi(v.x), bflo(v.y), bfhi(v.y)}; }
__device__ __forceinline__ unsigned pk2(float lo, float hi) { return pg8::cvt_pk_bf16(lo, hi); }
__device__ __forceinline__ u32x2 pack4(f32x4 v) { u32x2 r; r.x = pk2(v[0], v[1]); r.y = pk2(v[2], v[3]); return r; }
__device__ __forceinline__ float rcpf(float x) { return __builtin_amdgcn_rcpf(x); }
__device__ __forceinline__ float silu_f(float z) { return z * rcpf(1.f + __expf(-z)); }
__device__ __forceinline__ float sigm_f(float z) { return rcpf(1.f + __expf(-z)); }
__device__ __forceinline__ f32x4 silu4(f32x4 z) { return (f32x4){silu_f(z[0]), silu_f(z[1]), silu_f(z[2]), silu_f(z[3])}; }

struct Args { const float* in[16]; float* out; unsigned char* ws; int ph_lo, ph_hi; };
enum { I_X = 0, I_NORMW, I_WIN, I_POOLW, I_POOLS, I_CONVW, I_CONVB, I_WQ, I_WK, I_WV, I_WIF, I_BIF, I_MHNW, I_MSKIP, I_WOUT, I_FNW };

__device__ __forceinline__ void p0_transpose_item(const float* W, int ldw, int src_c0, bf16* WT, int K, int dst_r0, const float* kscale, float* scr, int kb, int nb, int lane) {
    const int k0 = 64 * kb, n0 = 32 * nb;
#pragma unroll 8
    for (int i = 0; i < 32; ++i) { const int kk = 2 * i + (lane >> 5); float v = W[(size_t)(k0 + kk) * ldw + src_c0 + n0 + (lane & 31)]; if (kscale) v *= kscale[k0 + kk]; scr[kk * 33 + (lane & 31)] = v; }
    asm volatile("s_waitcnt lgkmcnt(0)" ::: "memory");
    const int c = lane & 7;
#pragma unroll
    for (int j = 0; j < 4; ++j) { const int n = (lane >> 3) + 8 * j; const float* s = scr + (8 * c) * 33 + n;
        u32x4 o; o.x = pk2(s[0 * 33], s[1 * 33]); o.y = pk2(s[2 * 33], s[3 * 33]); o.z = pk2(s[4 * 33], s[5 * 33]); o.w = pk2(s[6 * 33], s[7 * 33]);
        *(u32x4*)(WT + (size_t)(dst_r0 + n0 + n) * K + k0 + 8 * c) = o; }
    asm volatile("s_waitcnt lgkmcnt(0)" ::: "memory");
}

__device__ __forceinline__ void p0_prologue(const Args& a, unsigned char* lds, int tid, int lane, int wave) {
    const int G = gridDim.x, bid = blockIdx.x;
    unsigned char* ws = a.ws;
    bf16* WtIn = (bf16*)(ws + WS_WIN); bf16* WtOut = (bf16*)(ws + WS_WOUT); bf16* XB = (bf16*)(ws + WS_XB);
    const float* w_in = a.in[I_WIN]; const float* norm_w = a.in[I_NORMW];
    {
        float* As = (float*)lds;
        float* Bs = As + 64 * 33;
        const float* pool_w = a.in[I_POOLW];
        for (int it = bid; it < 256; it += G) {
            const int g = it >> 6, kb = (it >> 2) & 15, db = it & 3, k0 = kb * 64, d0 = db * 64;
            const int dd = tid & 63, kq = tid >> 6;
            float acc[8];
#pragma unroll
            for (int i = 0; i < 8; ++i) acc[i] = 0.f;
            for (int c0 = 0; c0 < 256; c0 += 32) {
                __syncthreads();
#pragma unroll
                for (int i = 0; i < 4; ++i) { const int idx = tid + 512 * i; { const int kk = idx >> 5, cc = idx & 31; As[kk * 33 + cc] = w_in[(size_t)(k0 + kk) * NIN + g * 256 + c0 + cc]; }
                    { const int cc = idx >> 6, d2 = idx & 63; Bs[cc * 65 + d2] = pool_w[((size_t)g * 256 + c0 + cc) * 256 + d0 + d2]; } }
                __syncthreads();
#pragma unroll 8
                for (int cc = 0; cc < 32; ++cc) { const float b = Bs[cc * 65 + dd];
#pragma unroll
                    for (int i = 0; i < 8; ++i) acc[i] += As[(kq * 8 + i) * 33 + cc] * b; }
            }
            const f32x4 s0 = *(const f32x4*)(norm_w + k0 + kq * 8), s1 = *(const f32x4*)(norm_w + k0 + kq * 8 + 4);
            u32x4 o; o.x = pk2(acc[0] * s0[0], acc[1] * s0[1]); o.y = pk2(acc[2] * s0[2], acc[3] * s0[3]); o.z = pk2(acc[4] * s1[0], acc[5] * s1[1]); o.w = pk2(acc[6] * s1[2], acc[7] * s1[3]);
            *(u32x4*)(WtIn + (size_t)(g * 256 + d0 + dd) * DM + k0 + kq * 8) = o;
        }
        __syncthreads();
    }
    {
        float* scr = (float*)(lds + wave * 16384);
        const int gw = bid * NWAVES + wave, NGW = G * NWAVES;
        constexpr int I_SEG = (DM / 64) * (1024 / 32);
        constexpr int I_O = (2048 / 64) * (DM / 32);
        for (int it = gw; it < 4 * I_SEG + I_O; it += NGW) {
            if (it < 4 * I_SEG) { const int seg = it / I_SEG, r = it % I_SEG, kb = r / 32, nb = r % 32;
                const int src = seg == 0 ? 2048 : seg == 1 ? 1024 : seg == 2 ? 3072 : 4096;
                const int dst = seg == 0 ? C_MX : seg == 1 ? C_PZ : seg == 2 ? C_MZ : C_MO;
                p0_transpose_item(w_in, NIN, src, WtIn, DM, dst, norm_w, scr, kb, nb, lane);
            } else { const int r = it - 4 * I_SEG, kb = r / 32, nb = r % 32; p0_transpose_item(a.in[I_WOUT], DM, 0, WtOut, 2048, 0, nullptr, scr, kb, nb, lane); }
        }
    }
    {
        float* Gxc = (float*)(ws + WS_GXC); float* Gmx = (float*)(ws + WS_GMX);
        const float* wq = a.in[I_WQ]; const float* wk = a.in[I_WK]; const float* wv = a.in[I_WV]; const float* wif = a.in[I_WIF];
        for (int idx = bid * NTHR + tid; idx < 1024 * 8; idx += G * NTHR) { const int i = idx >> 3, j = idx & 7, n = i >> 2, c = i & 3;
            float sx = 0.f, sm = 0.f;
#pragma unroll
            for (int d = 0; d < 4; ++d) { sx += wq[n * 16 + c * 4 + d] * wif[(n * 4 + d) * 8 + j] + wk[n * 16 + c * 4 + d] * wif[(1024 + n * 4 + d) * 8 + j]; sm += wv[n * 16 + c * 4 + d] * wif[(2048 + n * 4 + d) * 8 + j]; }
            Gxc[idx] = sx; Gmx[idx] = sm; }
    }
    {
        const float* x = a.in[I_X]; float* rstd = (float*)(ws + WS_RSTD);
        const int gw = bid * NWAVES + wave, NGW = G * NWAVES;
        for (int m = gw; m < T; m += NGW) {
            const f32x4* xr = (const f32x4*)(x + (size_t)m * DM) + lane; f32x4 v[4]; float s = 0.f;
#pragma unroll
            for (int j = 0; j < 4; ++j) { v[j] = xr[64 * j]; s += (v[j][0] * v[j][0] + v[j][1] * v[j][1]) + (v[j][2] * v[j][2] + v[j][3] * v[j][3]); }
#pragma unroll
            for (int o = 1; o < 64; o <<= 1) s += __shfl_xor(s, o);
            if (lane == 0) rstd[m] = 1.0f / sqrtf(s * (1.f / DM) + EPS);
            u32x2* o8 = (u32x2*)(XB + (size_t)m * DM) + lane;
#pragma unroll
            for (int j = 0; j < 4; ++j) o8[64 * j] = pack4(v[j]);
        }
    }
}

template <int WIN>
__device__ __forceinline__ void pool_strip(bf16* PROJ, int t0, int g, int lane, const float* pool_scale, bf16* outp, int ldo) {
    const int c = g * 256 + 4 * lane;
    const bf16* py = PROJ + C_PY + c; bf16* pz = PROJ + C_PZ + c; bf16* pzo = outp + c;
    const f32x4 sc = *(const f32x4*)(pool_scale + c);
    const int p0 = t0 & (SEQ - 1);
    f32x4 S = (f32x4){0.f, 0.f, 0.f, 0.f};
    if (p0) {
#pragma unroll
        for (int j = 1; j <= WIN; ++j) S += cvt4(*(const u32x2*)(py + (size_t)(t0 - j) * LDP));
    }
    const float rw = 1.0f / WIN;
#pragma unroll 1
    for (int tb = 0; tb < 8; ++tb) {
        u32x2 cur[8], old[8], zz[8];
#pragma unroll
        for (int i = 0; i < 8; ++i) { const int pr = p0 + tb * 8 + i; const size_t ro = (size_t)(t0 + tb * 8 + i) * LDP; cur[i] = *(const u32x2*)(py + ro); zz[i] = *(const u32x2*)(pz + ro);
            old[i] = (u32x2){0u, 0u}; if (pr >= WIN) old[i] = *(const u32x2*)(py + ro - (size_t)WIN * LDP); }
#pragma unroll
        for (int i = 0; i < 8; ++i) {
            const f32x4 u = cvt4(cur[i]);
            S += u - cvt4(old[i]);
            const int pos = p0 + tb * 8 + i + 1; const float rc = pos >= WIN ? rw : 1.0f / (float)pos;
            const f32x4 d = S * rc - u; const f32x4 y = d * sc * silu4(cvt4(zz[i]));
            *(u32x2*)(pzo + (size_t)(t0 + tb * 8 + i) * ldo) = pack4(y);
        }
    }
}

__device__ __forceinline__ void mlstm_strip(const bf16* PROJ, bf16* XC, int t0, int h, int lane, const float* conv_w, const float* conv_b, const float* Gxc, const float* Gmx, float* gp) {
    const int c = h * 256 + 4 * lane;
    f32x4 cw[4];
#pragma unroll
    for (int j = 0; j < 4; ++j) cw[j] = *(const f32x4*)(conv_w + j * 1024 + c);
    const f32x4 cb = *(const f32x4*)(conv_b + c);
    f32x4 gx[4][2], gm[4][2];
#pragma unroll
    for (int cc = 0; cc < 4; ++cc) { gx[cc][0] = *(const f32x4*)(Gxc + (c + cc) * 8); gx[cc][1] = *(const f32x4*)(Gxc + (c + cc) * 8 + 4); gm[cc][0] = *(const f32x4*)(Gmx + (c + cc) * 8); gm[cc][1] = *(const f32x4*)(Gmx + (c + cc) * 8 + 4); }
    const bf16* mx = PROJ + C_MX + c;
    const int p0 = t0 & (SEQ - 1);
    f32x4 m1 = (f32x4){0.f, 0.f, 0.f, 0.f}, m2 = m1, m3 = m1;
    if (p0) { m1 = cvt4(*(const u32x2*)(mx + (size_t)(t0 - 1) * LDP)); m2 = cvt4(*(const u32x2*)(mx + (size_t)(t0 - 2) * LDP)); m3 = cvt4(*(const u32x2*)(mx + (size_t)(t0 - 3) * LDP)); }
    const bool hi5 = lane & 32, hi4 = lane & 16, hi3 = lane & 8;
    const int jj = (hi5 ? 4 : 0) + (hi4 ? 2 : 0) + (hi3 ? 1 : 0);
#pragma unroll 1
    for (int tb = 0; tb < 4; ++tb) {
        u32x2 cur[16];
#pragma unroll
        for (int i = 0; i < 16; ++i) cur[i] = *(const u32x2*)(mx + (size_t)(t0 + tb * 16 + i) * LDP);
#pragma unroll
        for (int i = 0; i < 16; ++i) {
            const f32x4 m0 = cvt4(cur[i]);
            const f32x4 cv = cb + cw[0] * m3 + cw[1] * m2 + cw[2] * m1 + cw[3] * m0;
            const f32x4 xc = silu4(cv);
            *(u32x2*)(XC + (size_t)(t0 + tb * 16 + i) * DM + c) = pack4(xc);
            f32x4 v0 = (f32x4){0.f, 0.f, 0.f, 0.f}, v1 = v0;
#pragma unroll
            for (int cc = 0; cc < 4; ++cc) { v0 += gx[cc][0] * xc[cc] + gm[cc][0] * m0[cc]; v1 += gx[cc][1] * xc[cc] + gm[cc][1] * m0[cc]; }
            f32x4 keep = hi5 ? v1 : v0, send = hi5 ? v0 : v1, r;
#pragma unroll
            for (int q = 0; q < 4; ++q) r[q] = keep[q] + __shfl_xor(send[q], 32);
            const float k0 = hi4 ? r[2] : r[0], k1 = hi4 ? r[3] : r[1], s0 = hi4 ? r[0] : r[2], s1 = hi4 ? r[1] : r[3];
            const float r0 = k0 + __shfl_xor(s0, 16), r1 = k1 + __shfl_xor(s1, 16);
            float z = (hi3 ? r1 : r0) + __shfl_xor(hi3 ? r0 : r1, 8);
            z += __shfl_xor(z, 4); z += __shfl_xor(z, 2); z += __shfl_xor(z, 1);
            if ((lane & 7) == 0) gp[(tb * 16 + i) * 8 + jj] = z;
            m3 = m2; m2 = m1; m1 = m0;
        }
    }
}

__device__ __forceinline__ void p2_tokenlocal(const Args& a, unsigned char* lds, int tid, int lane, int wave, bool dmy = false) {
    unsigned char* ws = a.ws; bf16* PROJ = (bf16*)(ws + WS_PROJ); bf16* XC = (bf16*)(ws + WS_XB);
    float* gates = (float*)(ws + WS_GATES); float* gpl = (float*)lds;
    bf16* po = dmy ? (bf16*)a.out : PROJ + C_PZ; const int ldo = dmy ? 1024 : LDP;
    for (int it = blockIdx.x; it < T / 64; it += gridDim.x) {
        const int t0 = it * 64;
        if (wave < 4) { switch (wave) { case 0: pool_strip<2>(PROJ, t0, 0, lane, a.in[I_POOLS], po, ldo); break; case 1: pool_strip<4>(PROJ, t0, 1, lane, a.in[I_POOLS], po, ldo); break;
                        case 2: pool_strip<8>(PROJ, t0, 2, lane, a.in[I_POOLS], po, ldo); break; default: pool_strip<16>(PROJ, t0, 3, lane, a.in[I_POOLS], po, ldo); break; } }
        else mlstm_strip(PROJ, XC, t0, wave - 4, lane, a.in[I_CONVW], a.in[I_CONVB], (const float*)(ws + WS_GXC), (const float*)(ws + WS_GMX), gpl + (wave - 4) * 512);
        __syncthreads();
        { const int j = tid & 7; gates[(size_t)t0 * 8 + tid] = a.in[I_BIF][j] + ((gpl[tid] + gpl[512 + tid]) + (gpl[1024 + tid] + gpl[1536 + tid])); }
        __syncthreads();
    }
}

__device__ __forceinline__ void gate_setup(float* sm, const float* gates, int t0, int h, int tid, float m_s, bool full) {
    float ig = 0.f;
    if (tid < 128) { const float f = gates[(size_t)(t0 + tid) * 8 + 4 + h]; ig = gates[(size_t)(t0 + tid) * 8 + h];
        sm[S_LF + tid] = fminf(f, 0.f) - log1pf(expf(-fabsf(f))); sm[S_IG + tid] = ig; }
    __syncthreads();
    if (tid < 128) { float b = 0.f; for (int j = 0; j <= tid; ++j) b += sm[S_LF + j]; sm[S_B + tid] = b; sm[S_COL + tid] = ig - b; }
    __syncthreads();
    const float g = sm[S_B + 127];
    if (tid < 128) sm[S_A + tid] = g - sm[S_B + tid] + ig;
    __syncthreads();
    if (tid < 64) { float v = fmaxf(sm[S_A + tid], sm[S_A + tid + 64]);
#pragma unroll
        for (int o = 32; o >= 1; o >>= 1) v = fmaxf(v, __shfl_xor(v, o));
        if (tid == 0) { sm[S_SC + 0] = g; sm[S_SC + 1] = v; } }
    if (full && tid < 128) { float pm = -INFINITY; for (int j = 0; j <= tid; ++j) pm = fmaxf(pm, sm[S_COL + j]);
        const float rowm = fmaxf(pm, m_s); sm[S_ROWM + tid] = rowm; sm[S_INTER + tid] = __expf(m_s - rowm); sm[S_FLOOR + tid] = __expf(-(sm[S_B + tid] + rowm)); }
    __syncthreads();
    if (tid < 128) sm[S_W + tid] = __expf(sm[S_A + tid] - sm[S_SC + 1]);
    __syncthreads();
}

__device__ __forceinline__ void stage_kv(unsigned char* lds, const bf16* XC, const bf16* PROJ, const float* wk, const float* wv, int t0, int h, int tid, const float* sw  ) {
    const int j8 = tid & 31, n0 = h * 64 + 2 * j8;
    f32x4 k_w[2][4], v_w[2][4];
#pragma unroll
    for (int b = 0; b < 2; ++b)
#pragma unroll
        for (int c = 0; c < 4; ++c) { k_w[b][c] = *(const f32x4*)(wk + (n0 + b) * 16 + c * 4) * 0.0625f; v_w[b][c] = *(const f32x4*)(wv + (n0 + b) * 16 + c * 4); }
#pragma unroll 2
    for (int itk = 0; itk < 8; ++itk) {
        const int l = (tid >> 5) + 16 * itk;
        const u32x4 xr = *(const u32x4*)(XC + (size_t)(t0 + l) * DM + h * 256 + 8 * j8);
        const u32x4 mr = *(const u32x4*)(PROJ + (size_t)(t0 + l) * LDP + C_MX + h * 256 + 8 * j8);
        const float wl = sw ? sw[l] : 1.0f;
        const float xf[8] = {bflo(xr.x), bfhi(xr.x), bflo(xr.y), bfhi(xr.y), bflo(xr.z), bfhi(xr.z), bflo(xr.w), bfhi(xr.w)};
        const float mf[8] = {bflo(mr.x), bfhi(mr.x), bflo(mr.y), bfhi(mr.y), bflo(mr.z), bfhi(mr.z), bflo(mr.w), bfhi(mr.w)};
        f32x4 ko[2], vo[2];
#pragma unroll
        for (int b = 0; b < 2; ++b) { ko[b] = k_w[b][0] * xf[4 * b] + k_w[b][1] * xf[4 * b + 1] + k_w[b][2] * xf[4 * b + 2] + k_w[b][3] * xf[4 * b + 3];
            vo[b] = (v_w[b][0] * mf[4 * b] + v_w[b][1] * mf[4 * b + 1] + v_w[b][2] * mf[4 * b + 2] + v_w[b][3] * mf[4 * b + 3]) * wl; }
        u32x4 kp, vp; kp.x = pk2(ko[0][0], ko[0][1]); kp.y = pk2(ko[0][2], ko[0][3]); kp.z = pk2(ko[1][0], ko[1][1]); kp.w = pk2(ko[1][2], ko[1][3]);
        vp.x = pk2(vo[0][0], vo[0][1]); vp.y = pk2(vo[0][2], vo[0][3]); vp.z = pk2(vo[1][0], vo[1][1]); vp.w = pk2(vo[1][2], vo[1][3]);
        *(u32x4*)(lds + TILE_A + l * RS + j8 * 16) = kp;
        *(u32x4*)(lds + TILE_B + l * RS + j8 * 16) = vp;
    }
}

#define TR_READ(dst, addr) asm volatile("ds_read_b64_tr_b16 %0, %1" : "=&v"(dst) : "v"(addr) : "memory")
__device__ __forceinline__ bf16x8 mk8(u32x2 lo, u32x2 hi) { u32x4 v; v.x = lo.x; v.y = lo.y; v.z = hi.x; v.w = hi.y; return __builtin_bit_cast(bf16x8, v); }

__device__ __forceinline__ void p3_kvlocal(const Args& a, unsigned char* lds, int tid, int lane, int wave) {
    unsigned char* ws = a.ws; const bf16* PROJ = (const bf16*)(ws + WS_PROJ); const bf16* XC = (const bf16*)(ws + WS_XB);
    const float* gates = (const float*)(ws + WS_GATES); bf16* KV = (bf16*)a.out;
    float* GC = (float*)(ws + WS_GC); float* AMAX = (float*)(ws + WS_AMAX); float* NLOC = (float*)(ws + WS_NLOC);
    float* sm = (float*)(lds + SM_OFF);
    const unsigned lbase = (unsigned)(size_t)lds;
    const int kg = lane >> 4, q = (lane & 15) >> 2, p = lane & 3;
    for (int it = blockIdx.x; it < NITEM; it += gridDim.x) {
        const int b = it >> 8, h = (it >> 6) & 3, c = it & 63, t0 = b * SEQ + c * CHK;
        gate_setup(sm, gates, t0, h, tid, 0.f, false);
        stage_kv(lds, XC, PROJ, a.in[I_WK], a.in[I_WV], t0, h, tid, sm + S_W);
        __syncthreads();
        if (tid == 0) { GC[it] = sm[S_SC + 0]; AMAX[it] = sm[S_SC + 1]; }
        if (tid < 256) { float s = 0.f; for (int l = 0; l < CHK; ++l) s += sm[S_W + l] * __uint_as_float((unsigned)(*(const bf16*)(lds + TILE_A + l * RS + tid * 2)) << 16); NLOC[(size_t)it * 256 + tid] = s; }
        f32x4 acc[2][16];
#pragma unroll
        for (int j = 0; j < 2; ++j)
#pragma unroll
            for (int d = 0; d < 16; ++d) acc[j][d] = (f32x4){0.f, 0.f, 0.f, 0.f};
        const unsigned kaddr = lbase + TILE_A + (8 * kg + q) * RS + 8 * p;
        const unsigned vaddr = lbase + TILE_B + (8 * kg + q) * RS + 8 * p + wave * 64;
#pragma unroll 1
        for (int ks = 0; ks < 4; ++ks) {
            u32x2 bl[2][2];
#pragma unroll
            for (int j = 0; j < 2; ++j)
#pragma unroll
                for (int t = 0; t < 2; ++t) TR_READ(bl[j][t], vaddr + (32 * ks + 4 * t) * RS + j * 32);
#pragma unroll
            for (int d4 = 0; d4 < 4; ++d4) {
                u32x2 al[4][2];
#pragma unroll
                for (int i = 0; i < 4; ++i)
#pragma unroll
                    for (int t = 0; t < 2; ++t) TR_READ(al[i][t], kaddr + (32 * ks + 4 * t) * RS + (d4 * 4 + i) * 32);
                asm volatile("s_waitcnt lgkmcnt(0)" : "+v"(al[0][0]), "+v"(al[0][1]), "+v"(al[1][0]), "+v"(al[1][1]), "+v"(al[2][0]), "+v"(al[2][1]), "+v"(al[3][0]), "+v"(al[3][1]),
                             "+v"(bl[0][0]), "+v"(bl[0][1]), "+v"(bl[1][0]), "+v"(bl[1][1]) :: "memory");
#pragma unroll
                for (int i = 0; i < 4; ++i)
#pragma unroll
                    for (int j = 0; j < 2; ++j) acc[j][d4 * 4 + i] = __builtin_amdgcn_mfma_f32_16x16x32_bf16(mk8(al[i][0], al[i][1]), mk8(bl[j][0], bl[j][1]), acc[j][d4 * 4 + i], 0, 0, 0);
            }
        }
        bf16* kvo = KV + (size_t)it * 65536;
#pragma unroll
        for (int j = 0; j < 2; ++j) { const int e = wave * 32 + j * 16 + (lane & 15);
#pragma unroll
            for (int d = 0; d < 16; ++d) *(u32x2*)(kvo + e * 256 + d * 16 + 4 * kg) = pack4(acc[j][d]); }
        __syncthreads();
    }
}

__device__ __forceinline__ void p4_scan(const Args& a, int tid) {
    unsigned char* ws = a.ws; bf16* KV = (bf16*)a.out;
    const float* GC = (const float*)(ws + WS_GC); const float* AMAX = (const float*)(ws + WS_AMAX); float* MS = (float*)(ws + WS_MS); float* NLOC = (float*)(ws + WS_NLOC);
    const int NT = gridDim.x * NTHR;
    for (int gt = blockIdx.x * NTHR + tid; gt < 8 * 16384; gt += NT) {
        const int bh = gt >> 14, off = (gt & 16383) * 4;
        f32x4 C = (f32x4){0.f, 0.f, 0.f, 0.f}; float m = 0.f;
        bf16* base = KV + (size_t)bh * 64 * 65536 + off;
#pragma unroll 1
        for (int cb = 0; cb < 64; cb += 16) {
            u32x2 kv[16];
#pragma unroll
            for (int i = 0; i < 16; ++i) kv[i] = *(const u32x2*)(base + (size_t)(cb + i) * 65536);
#pragma unroll
            for (int i = 0; i < 16; ++i) { const int item = bh * 64 + cb + i; const float g = GC[item], am = AMAX[item];
                if (off == 0) MS[item] = m;
                *(u32x2*)(base + (size_t)(cb + i) * 65536) = pack4(C);
                const float mn = fmaxf(g + m, am), dec = __expf(g + m - mn), scl = __expf(am - mn);
                C = C * dec + cvt4(kv[i]) * scl; m = mn; }
        }
    }
    for (int gt = blockIdx.x * NTHR + tid; gt < 8 * 256; gt += NT) {
        const int bh = gt >> 8, d = gt & 255; float n = 0.f, m = 0.f;
        for (int c = 0; c < 64; ++c) { const int item = bh * 64 + c; const float g = GC[item], am = AMAX[item]; const float nl = NLOC[(size_t)item * 256 + d];
            NLOC[(size_t)item * 256 + d] = n;
            const float mn = fmaxf(g + m, am); n = n * __expf(g + m - mn) + nl * __expf(am - mn); m = mn; }
    }
}

__device__ __forceinline__ void p5_mlstm_out(const Args& a, unsigned char* lds, int tid, int lane, int wave, bool dmy = false) {
    unsigned char* ws = a.ws; bf16* PROJ = (bf16*)(ws + WS_PROJ); const bf16* XC = (const bf16*)(ws + WS_XB);
    const float* gates = (const float*)(ws + WS_GATES); const bf16* KV = (const bf16*)a.out;
    const float* MS = (const float*)(ws + WS_MS); const float* NS = (const float*)(ws + WS_NLOC);
    const float* wq = a.in[I_WQ];
    float* sm = (float*)(lds + SM_OFF);
    const unsigned lbase = (unsigned)(size_t)lds;
    const int kg = lane >> 4, li = lane & 15, q = li >> 2, p = lane & 3;
    for (int it = blockIdx.x; it < NITEM; it += gridDim.x) {
        const int b = it >> 8, h = (it >> 6) & 3, c = it & 63, t0 = b * SEQ + c * CHK;
        const float m_s = MS[it];
        gate_setup(sm, gates, t0, h, tid, m_s, true);
        stage_kv(lds, XC, PROJ, a.in[I_WK], a.in[I_WV], t0, h, tid, nullptr);
        const int l = wave * 16 + li; const size_t trow = (size_t)(t0 + l);
        bf16x8 qf[8]; float nq = 0.f;
#pragma unroll
        for (int ks = 0; ks < 8; ++ks) {
            const int ch0 = h * 256 + 32 * ks + 8 * kg; const u32x4 xr = *(const u32x4*)(XC + trow * DM + ch0);
            const float xf[8] = {bflo(xr.x), bfhi(xr.x), bflo(xr.y), bfhi(xr.y), bflo(xr.z), bfhi(xr.z), bflo(xr.w), bfhi(xr.w)};
            f32x4 qo[2];
#pragma unroll
            for (int bb = 0; bb < 2; ++bb) { const float* w = wq + (size_t)((ch0 >> 2) + bb) * 16;
                qo[bb] = *(const f32x4*)(w) * xf[4 * bb] + *(const f32x4*)(w + 4) * xf[4 * bb + 1] + *(const f32x4*)(w + 8) * xf[4 * bb + 2] + *(const f32x4*)(w + 12) * xf[4 * bb + 3]; }
            const f32x4 n0 = *(const f32x4*)(NS + (size_t)it * 256 + 32 * ks + 8 * kg), n1 = *(const f32x4*)(NS + (size_t)it * 256 + 32 * ks + 8 * kg + 4);
            nq += (qo[0][0] * n0[0] + qo[0][1] * n0[1]) + (qo[0][2] * n0[2] + qo[0][3] * n0[3]) + (qo[1][0] * n1[0] + qo[1][1] * n1[1]) + (qo[1][2] * n1[2] + qo[1][3] * n1[3]);
            u32x4 pk; pk.x = pk2(qo[0][0], qo[0][1]); pk.y = pk2(qo[0][2], qo[0][3]); pk.z = pk2(qo[1][0], qo[1][1]); pk.w = pk2(qo[1][2], qo[1][3]);
            qf[ks] = __builtin_bit_cast(bf16x8, pk);
            asm volatile("" ::: "memory");
        }
        nq += __shfl_xor(nq, 16); nq += __shfl_xor(nq, 32);
        __syncthreads();
        const float rowm = sm[S_ROWM + l], inter = sm[S_INTER + l], flr = sm[S_FLOOR + l];
        f32x4 acc[16];
#pragma unroll
        for (int et = 0; et < 16; ++et) acc[et] = (f32x4){0.f, 0.f, 0.f, 0.f};
        float rowsum = 0.f;
        const unsigned vaddr = lbase + TILE_B + (4 * kg + q) * RS + 8 * p;
        const int ntp = (wave >> 1) + 1;
#pragma unroll 1
        for (int tp = 0; tp < ntp; ++tp) {
            f32x4 S0 = (f32x4){0.f, 0.f, 0.f, 0.f}, S1 = S0;
#pragma unroll
            for (int ks = 0; ks < 8; ++ks) { const bf16x8 a0 = *(const bf16x8*)(lds + TILE_A + (32 * tp + li) * RS + (32 * ks + 8 * kg) * 2); const bf16x8 a1 = *(const bf16x8*)(lds + TILE_A + (32 * tp + 16 + li) * RS + (32 * ks + 8 * kg) * 2);
                S0 = __builtin_amdgcn_mfma_f32_16x16x32_bf16(a0, qf[ks], S0, 0, 0, 0); S1 = __builtin_amdgcn_mfma_f32_16x16x32_bf16(a1, qf[ks], S1, 0, 0, 0); }
            const int s0 = 32 * tp + 4 * kg;
            const f32x4 c0 = *(const f32x4*)(sm + S_COL + s0), c1 = *(const f32x4*)(sm + S_COL + s0 + 16);
            f32x4 w0, w1;
#pragma unroll
            for (int r = 0; r < 4; ++r) { w0[r] = (s0 + r <= l) ? S0[r] * __expf(c0[r] - rowm) : 0.f; w1[r] = (s0 + 16 + r <= l) ? S1[r] * __expf(c1[r] - rowm) : 0.f; }
            rowsum += (w0[0] + w0[1]) + (w0[2] + w0[3]) + (w1[0] + w1[1]) + (w1[2] + w1[3]);
            u32x4 pp; pp.x = pk2(w0[0], w0[1]); pp.y = pk2(w0[2], w0[3]); pp.z = pk2(w1[0], w1[1]); pp.w = pk2(w1[2], w1[3]);
            const bf16x8 pf = __builtin_bit_cast(bf16x8, pp);
            const unsigned va = vaddr + (32 * tp) * RS;
#pragma unroll
            for (int e4 = 0; e4 < 4; ++e4) {
                u32x2 vl[4][2];
#pragma unroll
                for (int i = 0; i < 4; ++i) { TR_READ(vl[i][0], va + (e4 * 4 + i) * 32); TR_READ(vl[i][1], va + 16 * RS + (e4 * 4 + i) * 32); }
                asm volatile("s_waitcnt lgkmcnt(0)" : "+v"(vl[0][0]), "+v"(vl[0][1]), "+v"(vl[1][0]), "+v"(vl[1][1]), "+v"(vl[2][0]), "+v"(vl[2][1]), "+v"(vl[3][0]), "+v"(vl[3][1]) :: "memory");
#pragma unroll
                for (int i = 0; i < 4; ++i) acc[e4 * 4 + i] = __builtin_amdgcn_mfma_f32_16x16x32_bf16(mk8(vl[i][0], vl[i][1]), pf, acc[e4 * 4 + i], 0, 0, 0);
            }
        }
#pragma unroll
        for (int ks = 0; ks < 8; ++ks) { const u32x4 v = __builtin_bit_cast(u32x4, qf[ks]); u32x4 o;
            o.x = pk2(bflo(v.x) * inter, bfhi(v.x) * inter); o.y = pk2(bflo(v.y) * inter, bfhi(v.y) * inter); o.z = pk2(bflo(v.z) * inter, bfhi(v.z) * inter); o.w = pk2(bflo(v.w) * inter, bfhi(v.w) * inter);
            qf[ks] = __builtin_bit_cast(bf16x8, o); }
        __syncthreads();
        { const bf16* src = KV + (size_t)it * 65536;
#pragma unroll 4
          for (int i = 0; i < 16; ++i) { const int idx = tid + 512 * i, e = idx >> 5, ch = idx & 31; *(u32x4*)(lds + e * RS + ch * 16) = *(const u32x4*)(src + e * 256 + ch * 8); } }
        __syncthreads();
#pragma unroll
        for (int et = 0; et < 16; ++et) {
#pragma unroll
            for (int ks = 0; ks < 8; ++ks) { const bf16x8 af = *(const bf16x8*)(lds + (16 * et + li) * RS + (32 * ks + 8 * kg) * 2); acc[et] = __builtin_amdgcn_mfma_f32_16x16x32_bf16(af, qf[ks], acc[et], 0, 0, 0); }
            asm volatile("" ::: "memory");
        }
        rowsum += __shfl_xor(rowsum, 16); rowsum += __shfl_xor(rowsum, 32);
        const float den = rowsum + inter * nq; const float rinv = 1.0f / fmaxf(fabsf(den), flr);
        bf16* prow = PROJ + trow * LDP + h * 256 + 4 * kg;
        float sum = 0.f;
#pragma unroll
        for (int et = 0; et < 16; ++et) { const f32x4 mo = cvt4(*(const u32x2*)(prow + C_MO + 16 * et));
#pragma unroll
            for (int r = 0; r < 4; ++r) { acc[et][r] = acc[et][r] * rinv * sigm_f(mo[r]); sum += acc[et][r]; }
            if ((et & 3) == 3) asm volatile("" ::: "memory"); }
        sum += __shfl_xor(sum, 16); sum += __shfl_xor(sum, 32);
        const float mu = sum * (1.0f / 256.0f); float vs = 0.f;
#pragma unroll
        for (int et = 0; et < 16; ++et)
#pragma unroll
            for (int r = 0; r < 4; ++r) { const float dlt = acc[et][r] - mu; vs += dlt * dlt; }
        vs += __shfl_xor(vs, 16); vs += __shfl_xor(vs, 32);
        const float rstd = 1.0f / sqrtf(vs * (1.0f / 256.0f) + EPS);
        const float* nw = a.in[I_MHNW] + h * 256 + 4 * kg; const float* sk = a.in[I_MSKIP] + h * 256 + 4 * kg;
        const bf16* xcr = XC + trow * DM + h * 256 + 4 * kg;
#pragma unroll
        for (int et = 0; et < 16; ++et) { const f32x4 mz = cvt4(*(const u32x2*)(prow + C_MZ + 16 * et)); const f32x4 xc = cvt4(*(const u32x2*)(xcr + 16 * et));
            const f32x4 w4 = *(const f32x4*)(nw + 16 * et), s4 = *(const f32x4*)(sk + 16 * et);
            const f32x4 y = ((acc[et] - mu) * rstd * w4 + s4 * xc) * silu4(mz);
            *(u32x2*)(prow + (dmy ? C_PY : C_MZ) + 16 * et) = pack4(y);
            if (et & 1) asm volatile("" ::: "memory"); }
        __syncthreads();
    }
}

__device__ __forceinline__ void p7_final_norm(const Args& a, int lane, int wave, bool dmy = false) {
    const float* fw = a.in[I_FNW]; float* y = a.out;
    const int gw = blockIdx.x * NWAVES + wave, NGW = gridDim.x * NWAVES;
    f32x4 w[4];
#pragma unroll
    for (int j = 0; j < 4; ++j) w[j] = ((const f32x4*)fw)[lane + 64 * j];
    for (int m = gw; m < T; m += NGW) {
        f32x4* yr = (f32x4*)(y + (size_t)m * DM) + lane; f32x4 v[4]; float s = 0.f;
#pragma unroll
        for (int j = 0; j < 4; ++j) { v[j] = yr[64 * j]; s += (v[j][0] * v[j][0] + v[j][1] * v[j][1]) + (v[j][2] * v[j][2] + v[j][3] * v[j][3]); }
#pragma unroll
        for (int o = 1; o < 64; o <<= 1) s += __shfl_xor(s, o);
        const float r = 1.0f / sqrtf(s * (1.f / DM) + EPS);
#pragma unroll
        for (int j = 0; j < 4; ++j) (dmy ? (f32x4*)((float*)(a.ws + WS_PROJ) + (size_t)m * DM) + lane : yr)[64 * j] = v[j] * r * w[j];
    }
}


#define LAS __attribute__((address_space(3)))
#define XB_TMO      128
#define XB_XCNT(j)  (256  + 64 * (j))
#define XB_XSUB(j)  (1280 + 64 * (j))
#define XB_XGEN(j)  (2304 + 64 * (j))
#define XB_TOP      3328
#define XB_TOPGEN   3392
#define XCD_BAR_WORDS 3456
#define XB_SPIN_CAP (1u << 18)
__device__ __forceinline__ unsigned xb_ld(unsigned* p)              { return __hip_atomic_load(p, __ATOMIC_RELAXED, __HIP_MEMORY_SCOPE_AGENT); }
__device__ __forceinline__ unsigned xb_add(unsigned* p, unsigned v) { return __hip_atomic_fetch_add(p, v, __ATOMIC_RELAXED, __HIP_MEMORY_SCOPE_AGENT); }
__device__ __forceinline__ unsigned xb_xcc_id() { return (unsigned)__builtin_amdgcn_s_getreg((3 << 11) | 20) & 0xFu; }
#define XB_SPIN(cond, bar) do { unsigned _sp = 0; while (cond) { __builtin_amdgcn_s_sleep(1); \
    if ((++_sp & 255u) == 0u) { if (xb_ld(&(bar)[XB_TMO])) break; if (_sp > XB_SPIN_CAP) { atomicAdd(&(bar)[XB_TMO], 1u); break; } } } } while (0)
struct XcdBarrier { unsigned* bar; unsigned x; volatile LAS unsigned* st; };
__device__ __forceinline__ XcdBarrier xcd_barrier_post(unsigned* bar, volatile LAS unsigned* st) {
    XcdBarrier b; b.bar = bar; b.x = xb_xcc_id(); b.st = st;
    if (threadIdx.x == 0) (void)xb_add(&bar[XB_XCNT(b.x)], 1u);
    return b;
}
__device__ __forceinline__ void xcd_barrier_complete(unsigned* bar, unsigned x, unsigned& nloc, unsigned& nx) {
    const unsigned G = gridDim.x * gridDim.y * gridDim.z;
    unsigned sum, cnt, mine, sp = 0u;
    for (;;) {
        sum = 0u; cnt = 0u; mine = 0u;
#pragma unroll
        for (unsigned j = 0; j < 16; ++j) { const unsigned c = xb_ld(&bar[XB_XCNT(j)]); sum += c; cnt += (c > 0u) ? 1u : 0u; mine = (j == x) ? c : mine; }
        if (sum == G) break;
        __builtin_amdgcn_s_sleep(1);
        if ((++sp & 255u) == 0u) { if (xb_ld(&bar[XB_TMO])) break; if (sp > XB_SPIN_CAP) { atomicAdd(&bar[XB_TMO], 1u); break; } }
    }
    nloc = mine > 0u ? mine : 1u; nx = cnt > 0u ? cnt : 1u;
}
__device__ __forceinline__ void xcd_barrier(const XcdBarrier& b) {
    asm volatile("s_waitcnt vmcnt(0)" ::: "memory");
    __syncthreads();
    if (threadIdx.x == 0) {
        unsigned* bar = b.bar;
        __builtin_amdgcn_s_waitcnt(0);
        unsigned nloc = b.st[0], nx = b.st[1];
        if (nloc == 0u) { xcd_barrier_complete(bar, b.x, nloc, nx); b.st[0] = nloc; b.st[1] = nx; }
        const unsigned old = xb_add(&bar[XB_XSUB(b.x)], 1u);
        const unsigned gen = old / nloc;
        if (old + 1u == (gen + 1u) * nloc) {
            __builtin_amdgcn_fence(__ATOMIC_RELEASE, "agent");
            asm volatile("s_waitcnt vmcnt(0)" ::: "memory");
            const unsigned og = xb_add(&bar[XB_TOP], 1u);
            const unsigned tg = og / nx;
            if (og + 1u == (tg + 1u) * nx) xb_add(&bar[XB_TOPGEN], 1u);
            else XB_SPIN(xb_ld(&bar[XB_TOPGEN]) == tg, bar);
            __builtin_amdgcn_fence(__ATOMIC_ACQUIRE, "agent");
            xb_add(&bar[XB_XGEN(b.x)], 1u);
            asm volatile("s_waitcnt vmcnt(0)" ::: "memory");
        } else {
            XB_SPIN(xb_ld(&bar[XB_XGEN(b.x)]) == gen, bar);
            __builtin_amdgcn_fence(__ATOMIC_ACQUIRE, "agent");
            asm volatile("s_waitcnt vmcnt(0)" ::: "memory");
        }
    }
    __syncthreads();
}

__global__ void __launch_bounds__(NTHR) fwd_megakernel(Args args) {
    extern __shared__ __attribute__((aligned(16))) unsigned char lds[];
    cg::grid_group grid = cg::this_grid();
    const int tid = threadIdx.x, lane = tid & 63, wave = __builtin_amdgcn_readfirstlane(tid >> 6);
    const int lo = args.ph_lo, hi = args.ph_hi;
    unsigned char* ws = args.ws;
    if (tid < 16) ((LAS unsigned*)((LAS unsigned char*)lds + LDS_BARST))[tid] = 0u;
    __syncthreads();
    XcdBarrier bar = xcd_barrier_post((unsigned*)(ws + WS_BAR), (volatile LAS unsigned*)((LAS unsigned char*)lds + LDS_BARST));
    if (hi > 1000) grid.sync();
#define IN(k) (lo <= (k) && (k) < hi)
#if defined(PROBE_A)
    unsigned long long ts[9]; ts[0] = __builtin_amdgcn_s_memrealtime();
#define SEAM(k) do { if (IN(k) && IN((k) + 1)) xcd_barrier(bar); ts[(k) + 1] = __builtin_amdgcn_s_memrealtime(); } while (0)
#else
#define SEAM(k) do { if (IN(k) && IN((k) + 1)) { xcd_barrier(bar); if (PROBE_DUP == 8) xcd_barrier(bar); } } while (0)
#endif
    if (IN(0)) { p0_prologue(args, lds, tid, lane, wave); if (PROBE_DUP == 0) { __syncthreads(); p0_prologue(args, lds, tid, lane, wave); } }
    SEAM(0);
    if (IN(1)) { pg8::Gemm g{(const bf16*)(ws + WS_XB), (const bf16*)(ws + WS_WIN), T, NIN, DM, DM, DM}; pg8::StaticOrder S; S.init(T, NIN, gridDim.x, blockIdx.x);
        pg8::EpiProj E{(bf16*)(ws + WS_PROJ), LDP, (const float*)(ws + WS_RSTD)};
        pg8::gemm_phase<pg8::EpiProj, pg8::StaticOrder>((PG8_LAS unsigned char*)lds, g, S, E);
        if (PROBE_DUP == 1) pg8::gemm_phase<pg8::EpiProj, pg8::StaticOrder>((PG8_LAS unsigned char*)lds, g, S, E); }
    SEAM(1);
    if (IN(2)) { if (PROBE_DUP == 2) { p2_tokenlocal(args, lds, tid, lane, wave, true); __syncthreads(); } p2_tokenlocal(args, lds, tid, lane, wave); }
    SEAM(2);
    if (IN(3)) { p3_kvlocal(args, lds, tid, lane, wave); if (PROBE_DUP == 3) p3_kvlocal(args, lds, tid, lane, wave); }
    SEAM(3);
    if (IN(4)) p4_scan(args, tid);
    SEAM(4);
    if (IN(5)) { if (PROBE_DUP == 5) p5_mlstm_out(args, lds, tid, lane, wave, true); p5_mlstm_out(args, lds, tid, lane, wave); }
    SEAM(5);
    if (IN(6)) { pg8::Gemm g{(const bf16*)(ws + WS_PROJ) + C_PZ, (const bf16*)(ws + WS_WOUT), T, DM, 2048, LDP, 2048}; pg8::StaticOrder S; S.init(T, DM, gridDim.x, blockIdx.x);
        pg8::EpiResid E{args.in[I_X], args.out, DM};
        pg8::gemm_phase<pg8::EpiResid, pg8::StaticOrder>((PG8_LAS unsigned char*)lds, g, S, E);
        if (PROBE_DUP == 6) pg8::gemm_phase<pg8::EpiResid, pg8::StaticOrder>((PG8_LAS unsigned char*)lds, g, S, E); }
    SEAM(6);
    if (IN(7)) { if (PROBE_DUP == 7) p7_final_norm(args, lane, wave, true); p7_final_norm(args, lane, wave); }
#if defined(PROBE_A)
    grid.sync(); ts[8] = __builtin_amdgcn_s_memrealtime();
    if (blockIdx.x == 0) { const float tA = (float)(ts[PROBE_A + 1] - ts[PROBE_A]) * 0.01f, tB = (float)(ts[PROBE_B + 1] - ts[PROBE_B]) * 0.01f;
        if (tid == 0) args.out[0] += tA;
        for (int i = tid; i < 1600; i += NTHR) args.out[4096 + i] += tB * 0.25f; }
#endif
#undef IN
#undef SEAM
}

extern "C" void kernel_launch(void* const* d_in, const int* in_sizes, int n_in, void* d_out, int out_size, void* d_ws, size_t ws_size, hipStream_t stream) {
    static int grid = 0;
    if (grid == 0) {
        if (n_in != 16 || in_sizes[0] != T * DM || out_size != T * DM || ws_size < WS_END) { fprintf(stderr, "kernel_launch: unexpected shapes (n_in %d, ws %zu)\n", n_in, ws_size); grid = -1; return; }
        int dev = 0, cus = 0, per_cu = 0;
        hipGetDevice(&dev); hipDeviceGetAttribute(&cus, hipDeviceAttributeMultiprocessorCount, dev);
        hipFuncSetAttribute((const void*)fwd_megakernel, hipFuncAttributeMaxDynamicSharedMemorySize, LDS_BYTES);
        if (hipOccupancyMaxActiveBlocksPerMultiprocessor(&per_cu, (const void*)fwd_megakernel, NTHR, LDS_BYTES) != hipSuccess || per_cu < 1) { fprintf(stderr, "kernel_launch: occupancy query says %d blocks/CU\n", per_cu); per_cu = 1; }
        (void)hipGetLastError();
        grid = cus * 1;
        if (grid <= 0) grid = 256;
    }
    if (grid < 0) return;
    Args a{};
    for (int i = 0; i < 16; ++i) a.in[i] = (const float*)d_in[i];
    a.out = (float*)d_out; a.ws = (unsigned char*)d_ws;
#if MK_MULTI
    for (int ph = 0; ph < 8; ++ph) { a.ph_lo = ph; a.ph_hi = ph + 1; hipLaunchKernelGGL(fwd_megakernel, dim3(grid), dim3(NTHR), LDS_BYTES, stream, a); }
#else
    a.ph_lo = 0; a.ph_hi = 8;
    if (hipMemsetAsync((char*)d_ws + WS_BAR, 0, BAR_BYTES, stream) != hipSuccess) fprintf(stderr, "kernel_launch: memset of barrier words failed\n");
    void* kargs[] = {&a};
    hipError_t e = hipLaunchCooperativeKernel((const void*)fwd_megakernel, dim3(grid), dim3(NTHR), kargs, LDS_BYTES, stream);
    if (e != hipSuccess) fprintf(stderr, "cooperative launch failed: %s (grid %d)\n", hipGetErrorString(e), grid);
#endif
}
```

```cpp
#include <hip/hip_runtime.h>
#include <hip/hip_cooperative_groups.h>
#include <cstdio>
#include <cstdint>
namespace cg = cooperative_groups;

#ifndef PROBE_DUP
#define PROBE_DUP -1
#endif
#ifndef MK_MULTI
#define MK_MULTI 0
#endif

namespace pg8 {
#define PG8_LAS __attribute__((address_space(3)))
typedef unsigned short bf16_t;
typedef short bf16x8 __attribute__((ext_vector_type(8)));
typedef float f32x4 __attribute__((ext_vector_type(4)));
typedef unsigned u32x4 __attribute__((ext_vector_type(4)));
constexpr int BM = 256, BK = 64, HALF = 128, HTB = HALF * BK * 2, STAGE_BYTES = 8 * HTB, NXCD = 8, WGM = 8;

__host__ __device__ __forceinline__ int lds_byte(int r, int c) { const int st = (r >> 4) * 2 + (c >> 5), rr = r & 15, cc = c & 31, ob = rr * 64 + cc * 2; return st * 1024 + (ob ^ (((ob >> 9) & 1) << 5)); }
__host__ __device__ __forceinline__ void stage_rc(int b, int& R, int& C) { const int st = b / 1024, sb = b % 1024, swz = sb ^ (((sb >> 9) & 1) << 5); R = (st >> 1) * 16 + swz / 64; C = (st & 1) * 32 + (swz % 64) / 2; }
__host__ __device__ __forceinline__ int perm32(int rho) { const int n = rho >> 4, i = rho & 15; return 8 * (i >> 2) + 4 * n + (i & 3); }

struct Unit { int pm, pn; };
struct Gemm { const bf16_t* A; const bf16_t* Bt; int M, N, K, lda, ldb; };

struct StaticOrder {
    int nM, nN, nwg, G, c;
    __host__ __device__ void init(int M, int N, int G_, int c_) { nM = M / BM; nN = N / BM; nwg = nM * nN; G = G_; c = c_; }
    __host__ __device__ bool next(int i, Unit& u) const {
        const long L = (long)i * G + c; if (L >= nwg) return false;
        int wgid = (int)L; { const int q = nwg / NXCD, r = nwg % NXCD, xcd = wgid % NXCD, off = wgid / NXCD; wgid = (xcd < r ? xcd * (q + 1) : r * (q + 1) + (xcd - r) * q) + off; }
        const int nig = WGM * nN, gid = wgid / nig, fm = gid * WGM, gsz = (nM - fm) < WGM ? (nM - fm) : WGM;
        u.pm = fm + ((wgid % nig) % gsz); u.pn = (wgid % nig) / gsz; return true;
    }
};

__device__ __forceinline__ unsigned cvt_pk_bf16(float lo, float hi) { unsigned r; asm volatile("v_cvt_pk_bf16_f32 %0, %1, %2" : "=v"(r) : "v"(lo), "v"(hi)); return r; }

struct EpiProj {
    static constexpr bool PERM = true;
    bf16_t* O; int ldc; const float* rstd;
    __device__ __forceinline__ void operator()(const f32x4 (&acc)[2][2][4][2], const Unit& u, int wr, int wc, int fr, int fq) const {
        const int row0 = u.pm * BM + wr * 64 + fr; const int col0 = u.pn * BM + wc * 32 + 8 * fq;
#pragma unroll
        for (int ai = 0; ai < 2; ++ai)
#pragma unroll
            for (int m = 0; m < 4; ++m) { const int row = row0 + ai * HALF + m * 16; const float sc = rstd[row]; bf16_t* rowp = O + (size_t)row * ldc + col0;
#pragma unroll
                for (int bj = 0; bj < 2; ++bj) { f32x4 v0 = acc[ai][bj][m][0] * sc, v1 = acc[ai][bj][m][1] * sc;
                    u32x4 w; w.x = cvt_pk_bf16(v0[0], v0[1]); w.y = cvt_pk_bf16(v0[2], v0[3]); w.z = cvt_pk_bf16(v1[0], v1[1]); w.w = cvt_pk_bf16(v1[2], v1[3]);
                    *(u32x4*)(rowp + bj * HALF) = w; } }
    }
};
struct EpiResid {
    static constexpr bool PERM = false;
    const float* base; float* out; int ldc;
    __device__ __forceinline__ void operator()(const f32x4 (&acc)[2][2][4][2], const Unit& u, int wr, int wc, int fr, int fq) const {
        const int col0 = u.pn * BM + wc * 32 + 4 * fq;
#pragma unroll
        for (int ai = 0; ai < 2; ++ai)
#pragma unroll
            for (int m = 0; m < 4; ++m) { const size_t off = (size_t)(u.pm * BM + ai * HALF + wr * 64 + m * 16 + fr) * ldc + col0;
#pragma unroll
                for (int bj = 0; bj < 2; ++bj)
#pragma unroll
                    for (int n = 0; n < 2; ++n) { const f32x4 bs = *(const f32x4*)(base + off + bj * HALF + n * 16); *(f32x4*)(out + off + bj * HALF + n * 16) = bs + acc[ai][bj][m][n]; } }
    }
};

template <class Epi, class Sched>
__device__ __forceinline__ void gemm_phase(PG8_LAS unsigned char* lds, const Gemm g, const Sched& S, const Epi& E) {
    const int tid = threadIdx.x, wid = __builtin_amdgcn_readfirstlane(tid >> 6), lane = tid & 63, wr = wid >> 2, wc = wid & 3, fr = lane & 15, fq = lane >> 4;
    const int K = g.K, nt = K / BK;
    unsigned voffA[2], voffB[2];
#pragma unroll
    for (int i = 0; i < 2; ++i) { int R, C; stage_rc(tid * 16 + i * 8192, R, C); const int Rb = Epi::PERM ? ((R & ~31) + perm32(R & 31)) : R;
        voffA[i] = (unsigned)(R * g.lda + C) * 2u; voffB[i] = (unsigned)(Rb * g.ldb + C) * 2u; }
    const size_t kstep = (size_t)(BK * 2);
    const size_t hA = (size_t)HALF * g.lda * 2, hB = (size_t)HALF * g.ldb * 2;
    const size_t tA = 2 * hA, tB = 2 * hB;
    const unsigned ldsw = (unsigned)wid * 1024u;
    const int aoff = lds_byte(wr * 64 + fr, fq * 8), boff = lds_byte(wc * 32 + fr, fq * 8);
#define PG8_SA(b, h) (((b) * 2 + (h)) * HTB)
#define PG8_SB(b, h) ((4 + (b) * 2 + (h)) * HTB)
#define PG8_STAGE(bufoff, gbase, voff) do { _Pragma("unroll") for (int _i = 0; _i < 2; ++_i) \
        __builtin_amdgcn_global_load_lds((const unsigned*)((const char*)(gbase) + (voff)[_i]), (PG8_LAS unsigned*)(lds + (bufoff) + ldsw + _i * 8192), 16, 0, 0); } while (0)
#define PG8_LDA(dst, b, h) do { _Pragma("unroll") for (int m = 0; m < 4; ++m) _Pragma("unroll") for (int k = 0; k < 2; ++k) dst[m][k] = *(const PG8_LAS bf16x8*)(lds + PG8_SA(b, h) + aoff + m * 2048 + k * 1024); } while (0)
#define PG8_LDB(dst, b, h) do { _Pragma("unroll") for (int n = 0; n < 2; ++n) _Pragma("unroll") for (int k = 0; k < 2; ++k) dst[n][k] = *(const PG8_LAS bf16x8*)(lds + PG8_SB(b, h) + boff + n * 2048 + k * 1024); } while (0)
#define PG8_MMA(ai, bj, At, Bt) do { __builtin_amdgcn_s_setprio(1); _Pragma("unroll") for (int m = 0; m < 4; ++m) _Pragma("unroll") for (int n = 0; n < 2; ++n) _Pragma("unroll") for (int k = 0; k < 2; ++k) \
        acc[ai][bj][m][n] = __builtin_amdgcn_mfma_f32_16x16x32_bf16(Bt[n][k], At[m][k], acc[ai][bj][m][n], 0, 0, 0); __builtin_amdgcn_s_setprio(0); } while (0)
#define PG8_WAIT_V(n) asm volatile("s_waitcnt vmcnt(" #n ")" ::: "memory")
#define PG8_WAIT_L(n) asm volatile("s_waitcnt lgkmcnt(" #n ")" ::: "memory")
#define PG8_BAR __builtin_amdgcn_s_barrier()
#define PG8_SCHED __builtin_amdgcn_sched_barrier(0)
    Unit cur, nxt; int ui = 0;
    if (!S.next(0, cur)) return;
    f32x4 acc[2][2][4][2];
#pragma unroll
    for (int a = 0; a < 2; ++a)
#pragma unroll
        for (int b = 0; b < 2; ++b)
#pragma unroll
            for (int m = 0; m < 4; ++m)
#pragma unroll
                for (int n = 0; n < 2; ++n) acc[a][b][m][n] = (f32x4){0.f, 0.f, 0.f, 0.f};
    bf16x8 At[4][2], B0[2][2], B1[2][2];
    const char* cA = (const char*)g.A + (size_t)cur.pm * tA; const char* cB = (const char*)g.Bt + (size_t)cur.pn * tB;
    PG8_STAGE(PG8_SB(0, 0), cB, voffB); PG8_STAGE(PG8_SB(0, 1), cB + hB, voffB); PG8_STAGE(PG8_SA(0, 0), cA, voffA); PG8_STAGE(PG8_SA(0, 1), cA + hA, voffA);
    if (wr == 1) PG8_BAR;
    PG8_WAIT_V(2); PG8_BAR;
    PG8_STAGE(PG8_SB(1, 0), cB + kstep, voffB); PG8_STAGE(PG8_SA(1, 0), cA + kstep, voffA); PG8_STAGE(PG8_SB(1, 1), cB + hB + kstep, voffB);
    PG8_WAIT_V(6); PG8_BAR;
    for (;;) {
        const bool has_next = S.next(ui + 1, nxt);
        const char* nA = has_next ? (const char*)g.A + (size_t)nxt.pm * tA : cA; const char* nB = has_next ? (const char*)g.Bt + (size_t)nxt.pn * tB : cB;
        for (int t = 0; t < nt; t += 2) {
            const bool last = (t == nt - 2);
            const char* a1 = cA + (size_t)(t + 1) * kstep;
            const char* a2 = last ? nA : cA + (size_t)(t + 2) * kstep; const char* b2 = last ? nB : cB + (size_t)(t + 2) * kstep;
            const char* a3 = a2 + kstep; const char* b3 = b2 + kstep;
            PG8_LDB(B0, 0, 0); PG8_LDB(B1, 0, 1); PG8_SCHED; PG8_LDA(At, 0, 0); PG8_STAGE(PG8_SA(1, 1), a1 + hA, voffA);
            PG8_WAIT_V(8); PG8_WAIT_L(0); PG8_BAR; PG8_MMA(0, 0, At, B0); PG8_MMA(0, 1, At, B1); PG8_BAR; PG8_SCHED;
            PG8_LDA(At, 0, 1); PG8_STAGE(PG8_SB(0, 0), b2, voffB); PG8_STAGE(PG8_SB(0, 1), b2 + hB, voffB); PG8_STAGE(PG8_SA(0, 0), a2, voffA);
            PG8_WAIT_V(8); PG8_WAIT_L(0); PG8_BAR; PG8_MMA(1, 0, At, B0); PG8_MMA(1, 1, At, B1); PG8_BAR; PG8_SCHED;
            PG8_LDB(B0, 1, 0); PG8_LDB(B1, 1, 1); PG8_SCHED; PG8_LDA(At, 1, 0); PG8_STAGE(PG8_SA(0, 1), a2 + hA, voffA);
            PG8_WAIT_V(8); PG8_WAIT_L(0); PG8_BAR; PG8_MMA(0, 0, At, B0); PG8_MMA(0, 1, At, B1); PG8_BAR; PG8_SCHED;
            PG8_LDA(At, 1, 1); PG8_STAGE(PG8_SB(1, 0), b3, voffB); PG8_STAGE(PG8_SB(1, 1), b3 + hB, voffB); PG8_STAGE(PG8_SA(1, 0), a3, voffA);
            PG8_WAIT_V(8); PG8_WAIT_L(0); PG8_BAR; PG8_MMA(1, 0, At, B0); PG8_MMA(1, 1, At, B1); PG8_BAR; PG8_SCHED;
        }
        if (wr == 0) PG8_BAR;
        E(acc, cur, wr, wc, fr, fq);
        if (!has_next) break;
#pragma unroll
        for (int a = 0; a < 2; ++a)
#pragma unroll
            for (int b = 0; b < 2; ++b)
#pragma unroll
                for (int m = 0; m < 4; ++m)
#pragma unroll
                    for (int n = 0; n < 2; ++n) acc[a][b][m][n] = (f32x4){0.f, 0.f, 0.f, 0.f};
        cur = nxt; cA = nA; cB = nB; ++ui;
        if (wr == 1) PG8_BAR;
    }
    PG8_WAIT_V(0);
    PG8_BAR;
#undef PG8_SA
#undef PG8_SB
#undef PG8_STAGE
#undef PG8_LDA
#undef PG8_LDB
#undef PG8_MMA
#undef PG8_WAIT_V
#undef PG8_WAIT_L
#undef PG8_BAR
#undef PG8_SCHED
}
}

typedef unsigned short bf16;
typedef short bf16x8 __attribute__((ext_vector_type(8)));
typedef float f32x4 __attribute__((ext_vector_type(4)));
typedef unsigned u32x4 __attribute__((ext_vector_type(4)));
typedef unsigned u32x2 __attribute__((ext_vector_type(2)));

constexpr int NWAVES = 8, NTHR = 512;
constexpr int SEQ = 8192, NB = 2, T = NB * SEQ, DM = 1024, NIN = 5120, LDP = NIN;
constexpr int NH = 4, DH = 256, CHK = 128, NCH = SEQ / CHK, NITEM = NB * NH * NCH;
constexpr int C_PY = 0, C_MX = 1024, C_PZ = 2048, C_MZ = 3072, C_MO = 4096;
constexpr float EPS = 1e-6f;
constexpr size_t MiB = 1u << 20;
constexpr size_t WS_BAR = 131072, BAR_BYTES = 16384;
constexpr size_t WS_GXC = 0, WS_GMX = 32768, WS_GC = 65536, WS_AMAX = 65536 + 4096, WS_MS = 65536 + 8192;
constexpr size_t WS_RSTD = 1 * MiB, WS_GATES = 2 * MiB, WS_NLOC = 3 * MiB, WS_WIN = 4 * MiB, WS_WOUT = 14 * MiB, WS_XB = 18 * MiB, WS_PROJ = 50 * MiB, WS_END = 210 * MiB;
constexpr int LDS_BYTES = 147456, LDS_BARST = LDS_BYTES - 64;
constexpr int RS = 528;
constexpr int TILE_A = 0, TILE_B = 128 * RS, SM_OFF = 256 * RS;
static_assert(SM_OFF + 2816 * 4 <= LDS_BYTES - 64, "LDS map");
constexpr int S_B = 0, S_COL = 128, S_W = 256, S_ROWM = 384, S_INTER = 512, S_FLOOR = 640, S_SC = 768, S_WQ = 1024, S_NS = 2048, S_NW = 2304, S_SK = 2560;

__device__ __forceinline__ float bflo(unsigned u) { return __uint_as_float(u << 16); }
__device__ __forceinline__ float bfhi(unsigned u) { return __uint_as_float(u & 0xffff0000u); }
__device__ __forceinline__ f32x4 cvt4(u32x2 v) { return (f32x4){bflo(v.x), bfhi(v.x), bflo(v.y), bfhi(v.y)}; }
__device__ __forceinline__ unsigned pk2(float lo, float hi) { return pg8::cvt_pk_bf16(lo, hi); }
__device__ __forceinline__ u32x2 pack4(f32x4 v) { u32x2 r; r.x = pk2(v[0], v[1]); r.y = pk2(v[2], v[3]); return r; }
__device__ __forceinline__ float rcpf(float x) { return __builtin_amdgcn_rcpf(x); }
__device__ __forceinline__ float silu_f(float z) { return z * rcpf(1.f + __expf(-z)); }
__device__ __forceinline__ float sigm_f(float z) { return rcpf(1.f + __expf(-z)); }
__device__ __forceinline__ f32x4 silu4(f32x4 z) { return (f32x4){silu_f(z[0]), silu_f(z[1]), silu_f(z[2]), silu_f(z[3])}; }

struct Args { const float* in[16]; float* out; unsigned char* ws; int ph_lo, ph_hi; };
enum { I_X = 0, I_NORMW, I_WIN, I_POOLW, I_POOLS, I_CONVW, I_CONVB, I_WQ, I_WK, I_WV, I_WIF, I_BIF, I_MHNW, I_MSKIP, I_WOUT, I_FNW };

__device__ __forceinline__ void p0_transpose_item(const float* W, int ldw, int src_c0, bf16* WT, int K, int dst_r0, const float* kscale, float* scr, int kb, int nb, int lane) {
    const int k0 = 64 * kb, n0 = 32 * nb;
#pragma unroll 8
    for (int i = 0; i < 32; ++i) { const int kk = 2 * i + (lane >> 5); float v = W[(size_t)(k0 + kk) * ldw + src_c0 + n0 + (lane & 31)]; if (kscale) v *= kscale[k0 + kk]; scr[kk * 33 + (lane & 31)] = v; }
    asm volatile("s_waitcnt lgkmcnt(0)" ::: "memory");
    const int c = lane & 7;
#pragma unroll
    for (int j = 0; j < 4; ++j) { const int n = (lane >> 3) + 8 * j; const float* s = scr + (8 * c) * 33 + n;
        u32x4 o; o.x = pk2(s[0 * 33], s[1 * 33]); o.y = pk2(s[2 * 33], s[3 * 33]); o.z = pk2(s[4 * 33], s[5 * 33]); o.w = pk2(s[6 * 33], s[7 * 33]);
        *(u32x4*)(WT + (size_t)(dst_r0 + n0 + n) * K + k0 + 8 * c) = o; }
    asm volatile("s_waitcnt lgkmcnt(0)" ::: "memory");
}

__device__ __forceinline__ void p0_prologue(const Args& a, unsigned char* lds, int tid, int lane, int wave) {
    const int G = gridDim.x, bid = blockIdx.x;
    unsigned char* ws = a.ws;
    bf16* WtIn = (bf16*)(ws + WS_WIN); bf16* WtOut = (bf16*)(ws + WS_WOUT); bf16* XB = (bf16*)(ws + WS_XB);
    const float* w_in = a.in[I_WIN]; const float* norm_w = a.in[I_NORMW];
    {
        float* As = (float*)lds;
        float* Bs = As + 64 * 33;
        const float* pool_w = a.in[I_POOLW];
        for (int it = bid; it < 256; it += G) {
            const int g = it >> 6, kb = (it >> 2) & 15, db = it & 3, k0 = kb * 64, d0 = db * 64;
            const int dd = tid & 63, kq = tid >> 6;
            float acc[8];
#pragma unroll
            for (int i = 0; i < 8; ++i) acc[i] = 0.f;
            for (int c0 = 0; c0 < 256; c0 += 32) {
                __syncthreads();
#pragma unroll
                for (int i = 0; i < 4; ++i) { const int idx = tid + 512 * i; { const int kk = idx >> 5, cc = idx & 31; As[kk * 33 + cc] = w_in[(size_t)(k0 + kk) * NIN + g * 256 + c0 + cc]; }
                    { const int cc = idx >> 6, d2 = idx & 63; Bs[cc * 65 + d2] = pool_w[((size_t)g * 256 + c0 + cc) * 256 + d0 + d2]; } }
                __syncthreads();
#pragma unroll 8
                for (int cc = 0; cc < 32; ++cc) { const float b = Bs[cc * 65 + dd];
#pragma unroll
                    for (int i = 0; i < 8; ++i) acc[i] += As[(kq * 8 + i) * 33 + cc] * b; }
            }
            const f32x4 s0 = *(const f32x4*)(norm_w + k0 + kq * 8), s1 = *(const f32x4*)(norm_w + k0 + kq * 8 + 4);
            u32x4 o; o.x = pk2(acc[0] * s0[0], acc[1] * s0[1]); o.y = pk2(acc[2] * s0[2], acc[3] * s0[3]); o.z = pk2(acc[4] * s1[0], acc[5] * s1[1]); o.w = pk2(acc[6] * s1[2], acc[7] * s1[3]);
            *(u32x4*)(WtIn + (size_t)(g * 256 + d0 + dd) * DM + k0 + kq * 8) = o;
        }
        __syncthreads();
    }
    {
        float* scr = (float*)(lds + wave * 16384);
        const int gw = bid * NWAVES + wave, NGW = G * NWAVES;
        constexpr int I_SEG = (DM / 64) * (1024 / 32);
        constexpr int I_O = (2048 / 64) * (DM / 32);
        for (int it = gw; it < 4 * I_SEG + I_O; it += NGW) {
            if (it < 4 * I_SEG) { const int seg = it / I_SEG, r = it % I_SEG, kb = r / 32, nb = r % 32;
                const int src = seg == 0 ? 2048 : seg == 1 ? 1024 : seg == 2 ? 3072 : 4096;
                const int dst = seg == 0 ? C_MX : seg == 1 ? C_PZ : seg == 2 ? C_MZ : C_MO;
                p0_transpose_item(w_in, NIN, src, WtIn, DM, dst, norm_w, scr, kb, nb, lane);
            } else { const int r = it - 4 * I_SEG, kb = r / 32, nb = r % 32; p0_transpose_item(a.in[I_WOUT], DM, 0, WtOut, 2048, 0, nullptr, scr, kb, nb, lane); }
        }
    }
    {
        float* Gxc = (float*)(ws + WS_GXC); float* Gmx = (float*)(ws + WS_GMX);
        const float* wq = a.in[I_WQ]; const float* wk = a.in[I_WK]; const float* wv = a.in[I_WV]; const float* wif = a.in[I_WIF];
        for (int idx = bid * NTHR + tid; idx < 1024 * 8; idx += G * NTHR) { const int i = idx >> 3, j = idx & 7, n = i >> 2, c = i & 3;
            float sx = 0.f, sm = 0.f;
#pragma unroll
            for (int d = 0; d < 4; ++d) { sx += wq[n * 16 + c * 4 + d] * wif[(n * 4 + d) * 8 + j] + wk[n * 16 + c * 4 + d] * wif[(1024 + n * 4 + d) * 8 + j]; sm += wv[n * 16 + c * 4 + d] * wif[(2048 + n * 4 + d) * 8 + j]; }
            Gxc[idx] = sx; Gmx[idx] = sm; }
    }
    {
        const float* x = a.in[I_X]; float* rstd = (float*)(ws + WS_RSTD);
        const int gw = bid * NWAVES + wave, NGW = G * NWAVES;
        for (int m = gw; m < T; m += NGW) {
            const f32x4* xr = (const f32x4*)(x + (size_t)m * DM) + lane; f32x4 v[4]; float s = 0.f;
#pragma unroll
            for (int j = 0; j < 4; ++j) { v[j] = xr[64 * j]; s += (v[j][0] * v[j][0] + v[j][1] * v[j][1]) + (v[j][2] * v[j][2] + v[j][3] * v[j][3]); }
#pragma unroll
            for (int o = 1; o < 64; o <<= 1) s += __shfl_xor(s, o);
            if (lane == 0) rstd[m] = 1.0f / sqrtf(s * (1.f / DM) + EPS);
            u32x2* o8 = (u32x2*)(XB + (size_t)m * DM) + lane;
#pragma unroll
            for (int j = 0; j < 4; ++j) o8[64 * j] = pack4(v[j]);
        }
    }
}

template <int WIN>
__device__ __forceinline__ void pool_strip(bf16* PROJ, int t0, int g, int lane, const float* pool_scale, bf16* outp, int ldo) {
    const int c = g * 256 + 4 * lane;
    const bf16* py = PROJ + C_PY + c; bf16* pz = PROJ + C_PZ + c; bf16* pzo = outp + c;
    const f32x4 sc = *(const f32x4*)(pool_scale + c);
    const int p0 = t0 & (SEQ - 1);
    f32x4 S = (f32x4){0.f, 0.f, 0.f, 0.f};
    if (p0) {
#pragma unroll
        for (int j = 1; j <= WIN; ++j) S += cvt4(*(const u32x2*)(py + (size_t)(t0 - j) * LDP));
    }
    const float rw = 1.0f / WIN;
#pragma unroll 1
    for (int tb = 0; tb < 8; ++tb) {
        u32x2 cur[8], old[8], zz[8];
#pragma unroll
        for (int i = 0; i < 8; ++i) { const int pr = p0 + tb * 8 + i; const size_t ro = (size_t)(t0 + tb * 8 + i) * LDP; cur[i] = *(const u32x2*)(py + ro); zz[i] = *(const u32x2*)(pz + ro);
            old[i] = (u32x2){0u, 0u}; if (pr >= WIN) old[i] = *(const u32x2*)(py + ro - (size_t)WIN * LDP); }
#pragma unroll
        for (int i = 0; i < 8; ++i) {
            const f32x4 u = cvt4(cur[i]);
            S += u - cvt4(old[i]);
            const int pos = p0 + tb * 8 + i + 1; const float rc = pos >= WIN ? rw : 1.0f / (float)pos;
            const f32x4 d = S * rc - u; const f32x4 y = d * sc * silu4(cvt4(zz[i]));
            *(u32x2*)(pzo + (size_t)(t0 + tb * 8 + i) * ldo) = pack4(y);
        }
    }
}

__device__ __forceinline__ void mlstm_strip(const bf16* PROJ, bf16* XC, int t0, int h, int lane, const float* conv_w, const float* conv_b, const float* Gxc, const float* Gmx, float* gp) {
    const int c = h * 256 + 4 * lane;
    f32x4 cw[4];
#pragma unroll
    for (int j = 0; j < 4; ++j) cw[j] = *(const f32x4*)(conv_w + j * 1024 + c);
    const f32x4 cb = *(const f32x4*)(conv_b + c);
    f32x4 gx[4][2], gm[4][2];
#pragma unroll
    for (int cc = 0; cc < 4; ++cc) { gx[cc][0] = *(const f32x4*)(Gxc + (c + cc) * 8); gx[cc][1] = *(const f32x4*)(Gxc + (c + cc) * 8 + 4); gm[cc][0] = *(const f32x4*)(Gmx + (c + cc) * 8); gm[cc][1] = *(const f32x4*)(Gmx + (c + cc) * 8 + 4); }
    const bf16* mx = PROJ + C_MX + c;
    const int p0 = t0 & (SEQ - 1);
    f32x4 m1 = (f32x4){0.f, 0.f, 0.f, 0.f}, m2 = m1, m3 = m1;
    if (p0) { m1 = cvt4(*(const u32x2*)(mx + (size_t)(t0 - 1) * LDP)); m2 = cvt4(*(const u32x2*)(mx + (size_t)(t0 - 2) * LDP)); m3 = cvt4(*(const u32x2*)(mx + (size_t)(t0 - 3) * LDP)); }
    const bool hi5 = lane & 32, hi4 = lane & 16, hi3 = lane & 8;
    const int jj = (hi5 ? 4 : 0) + (hi4 ? 2 : 0) + (hi3 ? 1 : 0);
#pragma unroll 1
    for (int tb = 0; tb < 4; ++tb) {
        u32x2 cur[16];
#pragma unroll
        for (int i = 0; i < 16; ++i) cur[i] = *(const u32x2*)(mx + (size_t)(t0 + tb * 16 + i) * LDP);
#pragma unroll
        for (int i = 0; i < 16; ++i) {
            const f32x4 m0 = cvt4(cur[i]);
            const f32x4 cv = cb + cw[0] * m3 + cw[1] * m2 + cw[2] * m1 + cw[3] * m0;
            const f32x4 xc = silu4(cv);
            *(u32x2*)(XC + (size_t)(t0 + tb * 16 + i) * DM + c) = pack4(xc);
            f32x4 v0 = (f32x4){0.f, 0.f, 0.f, 0.f}, v1 = v0;
#pragma unroll
            for (int cc = 0; cc < 4; ++cc) { v0 += gx[cc][0] * xc[cc] + gm[cc][0] * m0[cc]; v1 += gx[cc][1] * xc[cc] + gm[cc][1] * m0[cc]; }
            f32x4 keep = hi5 ? v1 : v0, send = hi5 ? v0 : v1, r;
#pragma unroll
            for (int q = 0; q < 4; ++q) r[q] = keep[q] + __shfl_xor(send[q], 32);
            const float k0 = hi4 ? r[2] : r[0], k1 = hi4 ? r[3] : r[1], s0 = hi4 ? r[0] : r[2], s1 = hi4 ? r[1] : r[3];
            const float r0 = k0 + __shfl_xor(s0, 16), r1 = k1 + __shfl_xor(s1, 16);
            float z = (hi3 ? r1 : r0) + __shfl_xor(hi3 ? r0 : r1, 8);
            z += __shfl_xor(z, 4); z += __shfl_xor(z, 2); z += __shfl_xor(z, 1);
            if ((lane & 7) == 0) gp[(tb * 16 + i) * 8 + jj] = z;
            m3 = m2; m2 = m1; m1 = m0;
        }
    }
}

__device__ __forceinline__ void p2_tokenlocal(const Args& a, unsigned char* lds, int tid, int lane, int wave, bool dmy = false) {
    unsigned char* ws = a.ws; bf16* PROJ = (bf16*)(ws + WS_PROJ); bf16* XC = (bf16*)(ws + WS_XB);
    float* gates = (float*)(ws + WS_GATES); float* gpl = (float*)lds;
    bf16* po = dmy ? (bf16*)a.out : PROJ + C_PZ; const int ldo = dmy ? 1024 : LDP;
    for (int it = blockIdx.x; it < T / 64; it += gridDim.x) {
        const int t0 = it * 64;
        if (wave < 4) { switch (wave) { case 0: pool_strip<2>(PROJ, t0, 0, lane, a.in[I_POOLS], po, ldo); break; case 1: pool_strip<4>(PROJ, t0, 1, lane, a.in[I_POOLS], po, ldo); break;
                        case 2: pool_strip<8>(PROJ, t0, 2, lane, a.in[I_POOLS], po, ldo); break; default: pool_strip<16>(PROJ, t0, 3, lane, a.in[I_POOLS], po, ldo); break; } }
        else mlstm_strip(PROJ, XC, t0, wave - 4, lane, a.in[I_CONVW], a.in[I_CONVB], (const float*)(ws + WS_GXC), (const float*)(ws + WS_GMX), gpl + (wave - 4) * 512);
        __syncthreads();
        { const int j = tid & 7; gates[(size_t)t0 * 8 + tid] = a.in[I_BIF][j] + ((gpl[tid] + gpl[512 + tid]) + (gpl[1024 + tid] + gpl[1536 + tid])); }
        __syncthreads();
    }
}

__device__ __forceinline__ float wscan_sum(float v, int lane) {
#pragma unroll
    for (int o = 1; o < 64; o <<= 1) { const float t = __shfl_up(v, o); if (lane >= o) v += t; }
    return v; }
__device__ __forceinline__ float wscan_max(float v, int lane) {
#pragma unroll
    for (int o = 1; o < 64; o <<= 1) { const float t = __shfl_up(v, o); if (lane >= o) v = fmaxf(v, t); }
    return v; }
__device__ __forceinline__ void gate_setup(float* sm, const float* gates, int t0, int h, int tid, int lane, int wave, float m_s, bool full) {
    float ig = 0.f, b = 0.f, a = 0.f, pm = 0.f, g = 0.f;
    if (wave < 2) { const float f = gates[(size_t)(t0 + tid) * 8 + 4 + h]; ig = gates[(size_t)(t0 + tid) * 8 + h];
        const float lf = fminf(f, 0.f) - __logf(1.0f + __expf(-fabsf(f)));
        b = wscan_sum(lf, lane); if (lane == 63) sm[S_SC + 4 + wave] = b; }
    __syncthreads();
    if (wave < 2) { const float tot0 = sm[S_SC + 4], tot1 = sm[S_SC + 5]; if (wave == 1) b += tot0; g = tot0 + tot1;
        const float col = ig - b; a = g - b + ig;
        float mx = a;
#pragma unroll
        for (int o = 32; o >= 1; o >>= 1) mx = fmaxf(mx, __shfl_xor(mx, o));
        if (lane == 0) sm[S_SC + 6 + wave] = mx;
        pm = wscan_max(col, lane); if (lane == 63) sm[S_SC + 8 + wave] = pm;
        sm[S_B + tid] = b; sm[S_COL + tid] = col; }
    __syncthreads();
    if (wave < 2) { const float amax = fmaxf(sm[S_SC + 6], sm[S_SC + 7]); if (wave == 1) pm = fmaxf(pm, sm[S_SC + 8]);
        sm[S_W + tid] = __expf(a - amax); if (tid == 0) { sm[S_SC + 0] = g; sm[S_SC + 1] = amax; }
        if (full) { const float rowm = fmaxf(pm, m_s); sm[S_ROWM + tid] = rowm; sm[S_INTER + tid] = __expf(m_s - rowm); sm[S_FLOOR + tid] = __expf(-(b + rowm)); } }
    __syncthreads();
}

struct KvRegs { u32x4 xr[8], mr[8]; };
__device__ __forceinline__ void stage_kv_load(KvRegs& R, const bf16* XC, const bf16* PROJ, int t0, int h, int tid) {
    const int j8 = tid & 31;
#pragma unroll
    for (int itk = 0; itk < 8; ++itk) { const int l = (tid >> 5) + 16 * itk;
        R.xr[itk] = *(const u32x4*)(XC + (size_t)(t0 + l) * DM + h * 256 + 8 * j8);
        R.mr[itk] = *(const u32x4*)(PROJ + (size_t)(t0 + l) * LDP + C_MX + h * 256 + 8 * j8); }
}
__device__ __forceinline__ void stage_kv_store(const KvRegs& R, unsigned char* lds, const float* wk, const float* wv, int h, int tid, const float* sw  ) {
    const int j8 = tid & 31, n0 = h * 64 + 2 * j8;
    f32x4 k_w[2][4], v_w[2][4];
#pragma unroll
    for (int b = 0; b < 2; ++b)
#pragma unroll
        for (int c = 0; c < 4; ++c) { k_w[b][c] = *(const f32x4*)(wk + (n0 + b) * 16 + c * 4) * 0.0625f; v_w[b][c] = *(const f32x4*)(wv + (n0 + b) * 16 + c * 4); }
#pragma unroll
    for (int itk = 0; itk < 8; ++itk) {
        const int l = (tid >> 5) + 16 * itk;
        const u32x4 xr = R.xr[itk], mr = R.mr[itk];
        const float wl = sw ? sw[l] : 1.0f;
        const float xf[8] = {bflo(xr.x), bfhi(xr.x), bflo(xr.y), bfhi(xr.y), bflo(xr.z), bfhi(xr.z), bflo(xr.w), bfhi(xr.w)};
        const float mf[8] = {bflo(mr.x), bfhi(mr.x), bflo(mr.y), bfhi(mr.y), bflo(mr.z), bfhi(mr.z), bflo(mr.w), bfhi(mr.w)};
        f32x4 ko[2], vo[2];
#pragma unroll
        for (int b = 0; b < 2; ++b) { ko[b] = k_w[b][0] * xf[4 * b] + k_w[b][1] * xf[4 * b + 1] + k_w[b][2] * xf[4 * b + 2] + k_w[b][3] * xf[4 * b + 3];
            vo[b] = (v_w[b][0] * mf[4 * b] + v_w[b][1] * mf[4 * b + 1] + v_w[b][2] * mf[4 * b + 2] + v_w[b][3] * mf[4 * b + 3]) * wl; }
        u32x4 kp, vp; kp.x = pk2(ko[0][0], ko[0][1]); kp.y = pk2(ko[0][2], ko[0][3]); kp.z = pk2(ko[1][0], ko[1][1]); kp.w = pk2(ko[1][2], ko[1][3]);
        vp.x = pk2(vo[0][0], vo[0][1]); vp.y = pk2(vo[0][2], vo[0][3]); vp.z = pk2(vo[1][0], vo[1][1]); vp.w = pk2(vo[1][2], vo[1][3]);
        *(u32x4*)(lds + TILE_A + l * RS + j8 * 16) = kp;
        *(u32x4*)(lds + TILE_B + l * RS + j8 * 16) = vp;
    }
}

typedef short s16x4 __attribute__((ext_vector_type(4)));
__device__ __forceinline__ u32x2 tr_rd(const unsigned char* p) { return __builtin_bit_cast(u32x2, __builtin_amdgcn_ds_read_tr16_b64_v4i16((__attribute__((address_space(3))) s16x4*)p)); }
#define TR_READ(dst, addr) asm volatile("ds_read_b64_tr_b16 %0, %1" : "=&v"(dst) : "v"(addr) : "memory")
#define TR_READO(dst, addr, off) asm volatile("ds_read_b64_tr_b16 %0, %1 offset:%2" : "=&v"(dst) : "v"(addr), "i"(off) : "memory")
#define LGKM_WAIT8(v) asm volatile("s_waitcnt lgkmcnt(0)" : "+v"(v[0][0]), "+v"(v[0][1]), "+v"(v[1][0]), "+v"(v[1][1]), "+v"(v[2][0]), "+v"(v[2][1]), "+v"(v[3][0]), "+v"(v[3][1]) :: "memory")
__device__ __forceinline__ bf16x8 mk8(u32x2 lo, u32x2 hi) { u32x4 v; v.x = lo.x; v.y = lo.y; v.z = hi.x; v.w = hi.y; return __builtin_bit_cast(bf16x8, v); }

__device__ __forceinline__ void p3_kvlocal(const Args& a, unsigned char* lds, int tid, int lane, int wave) {
    unsigned char* ws = a.ws; const bf16* PROJ = (const bf16*)(ws + WS_PROJ); const bf16* XC = (const bf16*)(ws + WS_XB);
    const float* gates = (const float*)(ws + WS_GATES); bf16* KV = (bf16*)a.out;
    float* GC = (float*)(ws + WS_GC); float* AMAX = (float*)(ws + WS_AMAX); float* NLOC = (float*)(ws + WS_NLOC);
    float* sm = (float*)(lds + SM_OFF);
    const unsigned lbase = (unsigned)(size_t)lds;
    const int kg = lane >> 4, q = (lane & 15) >> 2, p = lane & 3;
    for (int it = blockIdx.x; it < NITEM; it += gridDim.x) {
        const int b = it >> 8, h = (it >> 6) & 3, c = it & 63, t0 = b * SEQ + c * CHK;
        int tv = tid; asm volatile("" : "+v"(tv));
        { KvRegs R; stage_kv_load(R, XC, PROJ, t0, h, tv);
          gate_setup(sm, gates, t0, h, tid, lane, wave, 0.f, false);
          stage_kv_store(R, lds, a.in[I_WK], a.in[I_WV], h, tv, sm + S_W); }
        __syncthreads();
        if (tid == 0) { GC[it] = sm[S_SC + 0]; AMAX[it] = sm[S_SC + 1]; }
        f32x4 acc[2][16];
#pragma unroll
        for (int j = 0; j < 2; ++j)
#pragma unroll
            for (int d = 0; d < 16; ++d) acc[j][d] = (f32x4){0.f, 0.f, 0.f, 0.f};
        const unsigned kaddr = lbase + TILE_A + (8 * kg + q) * RS + 8 * p;
        const unsigned vaddr = lbase + TILE_B + (8 * kg + q) * RS + 8 * p + wave * 64;
#pragma unroll 1
        for (int ks = 0; ks < 4; ++ks) {
            u32x2 bl[2][2];
#pragma unroll
            for (int j = 0; j < 2; ++j)
#pragma unroll
                for (int t = 0; t < 2; ++t) TR_READ(bl[j][t], vaddr + (32 * ks + 4 * t) * RS + j * 32);
#pragma unroll
            for (int d4 = 0; d4 < 4; ++d4) {
                u32x2 al[4][2];
#pragma unroll
                for (int i = 0; i < 4; ++i)
#pragma unroll
                    for (int t = 0; t < 2; ++t) TR_READ(al[i][t], kaddr + (32 * ks + 4 * t) * RS + (d4 * 4 + i) * 32);
                asm volatile("s_waitcnt lgkmcnt(0)" : "+v"(al[0][0]), "+v"(al[0][1]), "+v"(al[1][0]), "+v"(al[1][1]), "+v"(al[2][0]), "+v"(al[2][1]), "+v"(al[3][0]), "+v"(al[3][1]),
                             "+v"(bl[0][0]), "+v"(bl[0][1]), "+v"(bl[1][0]), "+v"(bl[1][1]) :: "memory");
#pragma unroll
                for (int i = 0; i < 4; ++i)
#pragma unroll
                    for (int j = 0; j < 2; ++j) acc[j][d4 * 4 + i] = __builtin_amdgcn_mfma_f32_16x16x32_bf16(mk8(al[i][0], al[i][1]), mk8(bl[j][0], bl[j][1]), acc[j][d4 * 4 + i], 0, 0, 0);
            }
        }
        bf16* kvo = KV + (size_t)it * 65536;
#pragma unroll
        for (int j = 0; j < 2; ++j) { const int e = wave * 32 + j * 16 + (lane & 15);
#pragma unroll
            for (int d = 0; d < 16; ++d) *(u32x2*)(kvo + e * 256 + d * 16 + 4 * kg) = pack4(acc[j][d]); }
        if (tid < 256) { float s0 = 0.f, s1 = 0.f;
#pragma unroll 8
            for (int l = 0; l < CHK; l += 2) { s0 += sm[S_W + l] * __uint_as_float((unsigned)(*(const bf16*)(lds + TILE_A + l * RS + tid * 2)) << 16); s1 += sm[S_W + l + 1] * __uint_as_float((unsigned)(*(const bf16*)(lds + TILE_A + (l + 1) * RS + tid * 2)) << 16); }
            NLOC[(size_t)it * 256 + tid] = s0 + s1; }
        __syncthreads();
    }
}

__device__ __forceinline__ void p4_scan(const Args& a, int tid) {
    unsigned char* ws = a.ws; bf16* KV = (bf16*)a.out;
    const float* GC = (const float*)(ws + WS_GC); const float* AMAX = (const float*)(ws + WS_AMAX); float* MS = (float*)(ws + WS_MS); float* NLOC = (float*)(ws + WS_NLOC);
    const int NT = gridDim.x * NTHR;
    for (int gt = blockIdx.x * NTHR + tid; gt < 8 * 16384; gt += NT) {
        const int bh = gt >> 14, off = (gt & 16383) * 4;
        f32x4 C = (f32x4){0.f, 0.f, 0.f, 0.f}; float m = 0.f;
        bf16* base = KV + (size_t)bh * 64 * 65536 + off;
#pragma unroll 1
        for (int cb = 0; cb < 64; cb += 16) {
            u32x2 kv[16];
#pragma unroll
            for (int i = 0; i < 16; ++i) kv[i] = *(const u32x2*)(base + (size_t)(cb + i) * 65536);
#pragma unroll
            for (int i = 0; i < 16; ++i) { const int item = bh * 64 + cb + i; const float g = GC[item], am = AMAX[item];
                if (off == 0) MS[item] = m;
                *(u32x2*)(base + (size_t)(cb + i) * 65536) = pack4(C);
                const float mn = fmaxf(g + m, am), dec = __expf(g + m - mn), scl = __expf(am - mn);
                C = C * dec + cvt4(kv[i]) * scl; m = mn; }
        }
    }
    for (int gt = blockIdx.x * NTHR + tid; gt < 8 * 256; gt += NT) {
        const int bh = gt >> 8, d = gt & 255; float n = 0.f, m = 0.f;
        for (int c = 0; c < 64; ++c) { const int item = bh * 64 + c; const float g = GC[item], am = AMAX[item]; const float nl = NLOC[(size_t)item * 256 + d];
            NLOC[(size_t)item * 256 + d] = n;
            const float mn = fmaxf(g + m, am); n = n * __expf(g + m - mn) + nl * __expf(am - mn); m = mn; }
    }
}

__device__ __forceinline__ void p5_mlstm_out(const Args& a, unsigned char* lds, int tid, int lane, int wave, bool dmy = false) {
    unsigned char* ws = a.ws; bf16* PROJ = (bf16*)(ws + WS_PROJ); const bf16* XC = (const bf16*)(ws + WS_XB);
    const float* gates = (const float*)(ws + WS_GATES); const bf16* KV = (const bf16*)a.out;
    const float* MS = (const float*)(ws + WS_MS); const float* NS = (const float*)(ws + WS_NLOC);
    float* sm = (float*)(lds + SM_OFF);
    const unsigned lbase = (unsigned)(size_t)lds;
    const int kg = lane >> 4, li = lane & 15, q = li >> 2, p = lane & 3;
    for (int it = blockIdx.x; it < NITEM; it += gridDim.x) {
        const int b = it >> 8, h = (it >> 6) & 3, c = it & 63, t0 = b * SEQ + c * CHK;
        const int l = wave * 16 + li; const size_t trow = (size_t)(t0 + l);
        const float m_s = MS[it];
        int tv = tid; asm volatile("" : "+v"(tv));
        if (wave >= 4) { const int i4 = (tv - 256) * 4; *(f32x4*)(sm + S_WQ + i4) = *(const f32x4*)(a.in[I_WQ] + h * 1024 + i4); }
        else if (wave < 3) { const int i4 = (tv & 63) * 4; const float* src = wave == 0 ? NS + (size_t)it * 256 : wave == 1 ? a.in[I_MHNW] + h * 256 : a.in[I_MSKIP] + h * 256;
            *(f32x4*)(sm + (wave == 0 ? S_NS : wave == 1 ? S_NW : S_SK) + i4) = *(const f32x4*)(src + i4); }
        u32x4 xq[8];
#pragma unroll
        for (int ks = 0; ks < 8; ++ks) xq[ks] = *(const u32x4*)(XC + trow * DM + h * 256 + 32 * ks + 8 * kg);
        { KvRegs R; stage_kv_load(R, XC, PROJ, t0, h, tv);
          gate_setup(sm, gates, t0, h, tid, lane, wave, m_s, true);
          stage_kv_store(R, lds, a.in[I_WK], a.in[I_WV], h, tv, nullptr); }
        bf16x8 qf[8]; float nq = 0.f;
#pragma unroll
        for (int ks = 0; ks < 8; ++ks) {
            const u32x4 xr = xq[ks];
            const float xf[8] = {bflo(xr.x), bfhi(xr.x), bflo(xr.y), bfhi(xr.y), bflo(xr.z), bfhi(xr.z), bflo(xr.w), bfhi(xr.w)};
            f32x4 qo[2];
#pragma unroll
            for (int bb = 0; bb < 2; ++bb) { const float* w = sm + S_WQ + (8 * ks + 2 * kg + bb) * 16;
                qo[bb] = *(const f32x4*)(w) * xf[4 * bb] + *(const f32x4*)(w + 4) * xf[4 * bb + 1] + *(const f32x4*)(w + 8) * xf[4 * bb + 2] + *(const f32x4*)(w + 12) * xf[4 * bb + 3]; }
            const f32x4 n0 = *(const f32x4*)(sm + S_NS + 32 * ks + 8 * kg), n1 = *(const f32x4*)(sm + S_NS + 32 * ks + 8 * kg + 4);
            nq += (qo[0][0] * n0[0] + qo[0][1] * n0[1]) + (qo[0][2] * n0[2] + qo[0][3] * n0[3]) + (qo[1][0] * n1[0] + qo[1][1] * n1[1]) + (qo[1][2] * n1[2] + qo[1][3] * n1[3]);
            u32x4 pk; pk.x = pk2(qo[0][0], qo[0][1]); pk.y = pk2(qo[0][2], qo[0][3]); pk.z = pk2(qo[1][0], qo[1][1]); pk.w = pk2(qo[1][2], qo[1][3]);
            qf[ks] = __builtin_bit_cast(bf16x8, pk);
        }
        nq += __shfl_xor(nq, 16); nq += __shfl_xor(nq, 32);
        __syncthreads();
        const bf16* csrc = KV + (size_t)it * 65536 + (tv >> 5) * 256 + (tv & 31) * 8;
        u32x4 cs[8];
#pragma unroll
        for (int i = 0; i < 8; ++i) cs[i] = *(const u32x4*)(csrc + i * 16 * 256);
        const float rowm = sm[S_ROWM + l], inter = sm[S_INTER + l], flr = sm[S_FLOOR + l];
        f32x4 acc[16];
#pragma unroll
        for (int et = 0; et < 16; ++et) acc[et] = (f32x4){0.f, 0.f, 0.f, 0.f};
        float rowsum = 0.f;
        const unsigned vaddr = lbase + TILE_B + (4 * kg + q) * RS + 8 * p;
        const int ntp = (wave >> 1) + 1;
#pragma unroll 1
        for (int tp = 0; tp < ntp; ++tp) {
            const unsigned va = vaddr + (32 * tp) * RS;
            f32x4 S0 = (f32x4){0.f, 0.f, 0.f, 0.f}, S1 = S0;
#pragma unroll
            for (int ks = 0; ks < 8; ++ks) { const bf16x8 a0 = *(const bf16x8*)(lds + TILE_A + (32 * tp + li) * RS + (32 * ks + 8 * kg) * 2); const bf16x8 a1 = *(const bf16x8*)(lds + TILE_A + (32 * tp + 16 + li) * RS + (32 * ks + 8 * kg) * 2);
                S0 = __builtin_amdgcn_mfma_f32_16x16x32_bf16(a0, qf[ks], S0, 0, 0, 0); S1 = __builtin_amdgcn_mfma_f32_16x16x32_bf16(a1, qf[ks], S1, 0, 0, 0); }
            const int s0 = 32 * tp + 4 * kg;
            const f32x4 c0 = *(const f32x4*)(sm + S_COL + s0), c1 = *(const f32x4*)(sm + S_COL + s0 + 16);
            f32x4 w0, w1;
#pragma unroll
            for (int r = 0; r < 4; ++r) { w0[r] = (s0 + r <= l) ? S0[r] * __expf(c0[r] - rowm) : 0.f; w1[r] = (s0 + 16 + r <= l) ? S1[r] * __expf(c1[r] - rowm) : 0.f; }
            rowsum += (w0[0] + w0[1]) + (w0[2] + w0[3]) + (w1[0] + w1[1]) + (w1[2] + w1[3]);
            u32x4 pp; pp.x = pk2(w0[0], w0[1]); pp.y = pk2(w0[2], w0[3]); pp.z = pk2(w1[0], w1[1]); pp.w = pk2(w1[2], w1[3]);
            const bf16x8 pf = __builtin_bit_cast(bf16x8, pp);
#pragma unroll
            for (int e4 = 0; e4 < 4; ++e4) {
                u32x2 vl[4][2];
#pragma unroll
                for (int i = 0; i < 4; ++i) { TR_READO(vl[i][0], va, (e4 * 4 + i) * 32); TR_READO(vl[i][1], va, 16 * RS + (e4 * 4 + i) * 32); }
                LGKM_WAIT8(vl);
#pragma unroll
                for (int i = 0; i < 4; ++i) acc[e4 * 4 + i] = __builtin_amdgcn_mfma_f32_16x16x32_bf16(mk8(vl[i][0], vl[i][1]), pf, acc[e4 * 4 + i], 0, 0, 0);
            }
        }
#pragma unroll
        for (int ks = 0; ks < 8; ++ks) { const u32x4 v = __builtin_bit_cast(u32x4, qf[ks]); u32x4 o;
            o.x = pk2(bflo(v.x) * inter, bfhi(v.x) * inter); o.y = pk2(bflo(v.y) * inter, bfhi(v.y) * inter); o.z = pk2(bflo(v.z) * inter, bfhi(v.z) * inter); o.w = pk2(bflo(v.w) * inter, bfhi(v.w) * inter);
            qf[ks] = __builtin_bit_cast(bf16x8, o); }
        __syncthreads();
        unsigned char* cdst = lds + (tv >> 5) * RS + (tv & 31) * 16;
#pragma unroll
        for (int i = 0; i < 8; ++i) *(u32x4*)(cdst + i * 16 * RS) = cs[i];
#pragma unroll
        for (int i = 0; i < 8; ++i) cs[i] = *(const u32x4*)(csrc + (i + 8) * 16 * 256);
        bf16* prow = PROJ + trow * LDP + h * 256 + 4 * kg;
        const bf16* xcr = XC + trow * DM + h * 256 + 4 * kg;
        u32x2 mo[16];
#pragma unroll
        for (int et = 0; et < 16; ++et) mo[et] = *(const u32x2*)(prow + C_MO + 16 * et);
#pragma unroll
        for (int i = 0; i < 8; ++i) *(u32x4*)(cdst + (i + 8) * 16 * RS) = cs[i];
        __syncthreads();
#pragma unroll
        for (int et = 0; et < 16; ++et) {
#pragma unroll
            for (int ks = 0; ks < 8; ++ks) { const bf16x8 af = *(const bf16x8*)(lds + (16 * et + li) * RS + (32 * ks + 8 * kg) * 2); acc[et] = __builtin_amdgcn_mfma_f32_16x16x32_bf16(af, qf[ks], acc[et], 0, 0, 0); }
            asm volatile("" ::: "memory");
        }
        u32x2 mzr[16], xcv[16];
#pragma unroll
        for (int et = 0; et < 16; ++et) { mzr[et] = *(const u32x2*)(prow + C_MZ + 16 * et); xcv[et] = *(const u32x2*)(xcr + 16 * et); }
        rowsum += __shfl_xor(rowsum, 16); rowsum += __shfl_xor(rowsum, 32);
        const float den = rowsum + inter * nq; const float rinv = rcpf(fmaxf(fabsf(den), flr));
        float sum = 0.f;
#pragma unroll
        for (int et = 0; et < 16; ++et) { const f32x4 mv = cvt4(mo[et]);
#pragma unroll
            for (int r = 0; r < 4; ++r) { acc[et][r] = acc[et][r] * rinv * sigm_f(mv[r]); sum += acc[et][r]; } }
        sum += __shfl_xor(sum, 16); sum += __shfl_xor(sum, 32);
        const float mu = sum * (1.0f / 256.0f); float vs = 0.f;
#pragma unroll
        for (int et = 0; et < 16; ++et)
#pragma unroll
            for (int r = 0; r < 4; ++r) { const float dlt = acc[et][r] - mu; vs += dlt * dlt; }
        vs += __shfl_xor(vs, 16); vs += __shfl_xor(vs, 32);
        const float rstd = __builtin_amdgcn_rsqf(vs * (1.0f / 256.0f) + EPS);
#pragma unroll
        for (int et = 0; et < 16; ++et) { const f32x4 mz = cvt4(mzr[et]); const f32x4 xc = cvt4(xcv[et]);
            const f32x4 w4 = *(const f32x4*)(sm + S_NW + 16 * et + 4 * kg), s4 = *(const f32x4*)(sm + S_SK + 16 * et + 4 * kg);
            const f32x4 y = ((acc[et] - mu) * rstd * w4 + s4 * xc) * silu4(mz);
            *(u32x2*)(prow + (dmy ? C_PY : C_MZ) + 16 * et) = pack4(y); }
        __syncthreads();
    }
}

__device__ __forceinline__ void p7_final_norm(const Args& a, int lane, int wave, bool dmy = false) {
    const float* fw = a.in[I_FNW]; float* y = a.out;
    const int gw = blockIdx.x * NWAVES + wave, NGW = gridDim.x * NWAVES;
    f32x4 w[4];
#pragma unroll
    for (int j = 0; j < 4; ++j) w[j] = ((const f32x4*)fw)[lane + 64 * j];
    for (int m = gw; m < T; m += NGW) {
        f32x4* yr = (f32x4*)(y + (size_t)m * DM) + lane; f32x4 v[4]; float s = 0.f;
#pragma unroll
        for (int j = 0; j < 4; ++j) { v[j] = yr[64 * j]; s += (v[j][0] * v[j][0] + v[j][1] * v[j][1]) + (v[j][2] * v[j][2] + v[j][3] * v[j][3]); }
#pragma unroll
        for (int o = 1; o < 64; o <<= 1) s += __shfl_xor(s, o);
        const float r = 1.0f / sqrtf(s * (1.f / DM) + EPS);
#pragma unroll
        for (int j = 0; j < 4; ++j) (dmy ? (f32x4*)((float*)(a.ws + WS_PROJ) + (size_t)m * DM) + lane : yr)[64 * j] = v[j] * r * w[j];
    }
}


#define LAS __attribute__((address_space(3)))
#define XB_TMO      128
#define XB_XCNT(j)  (256  + 64 * (j))
#define XB_XSUB(j)  (1280 + 64 * (j))
#define XB_XGEN(j)  (2304 + 64 * (j))
#define XB_TOP      3328
#define XB_TOPGEN   3392
#define XCD_BAR_WORDS 3456
#define XB_SPIN_CAP (1u << 18)
__device__ __forceinline__ unsigned xb_ld(unsigned* p)              { return __hip_atomic_load(p, __ATOMIC_RELAXED, __HIP_MEMORY_SCOPE_AGENT); }
__device__ __forceinline__ unsigned xb_add(unsigned* p, unsigned v) { return __hip_atomic_fetch_add(p, v, __ATOMIC_RELAXED, __HIP_MEMORY_SCOPE_AGENT); }
__device__ __forceinline__ unsigned xb_xcc_id() { return (unsigned)__builtin_amdgcn_s_getreg((3 << 11) | 20) & 0xFu; }
#define XB_SPIN(cond, bar) do { unsigned _sp = 0; while (cond) { __builtin_amdgcn_s_sleep(1); \
    if ((++_sp & 255u) == 0u) { if (xb_ld(&(bar)[XB_TMO])) break; if (_sp > XB_SPIN_CAP) { atomicAdd(&(bar)[XB_TMO], 1u); break; } } } } while (0)
struct XcdBarrier { unsigned* bar; unsigned x; volatile LAS unsigned* st; };
__device__ __forceinline__ XcdBarrier xcd_barrier_post(unsigned* bar, volatile LAS unsigned* st) {
    XcdBarrier b; b.bar = bar; b.x = xb_xcc_id(); b.st = st;
    if (threadIdx.x == 0) (void)xb_add(&bar[XB_XCNT(b.x)], 1u);
    return b;
}
__device__ __forceinline__ void xcd_barrier_complete(unsigned* bar, unsigned x, unsigned& nloc, unsigned& nx) {
    const unsigned G = gridDim.x * gridDim.y * gridDim.z;
    unsigned sum, cnt, mine, sp = 0u;
    for (;;) {
        sum = 0u; cnt = 0u; mine = 0u;
#pragma unroll
        for (unsigned j = 0; j < 16; ++j) { const unsigned c = xb_ld(&bar[XB_XCNT(j)]); sum += c; cnt += (c > 0u) ? 1u : 0u; mine = (j == x) ? c : mine; }
        if (sum == G) break;
        __builtin_amdgcn_s_sleep(1);
        if ((++sp & 255u) == 0u) { if (xb_ld(&bar[XB_TMO])) break; if (sp > XB_SPIN_CAP) { atomicAdd(&bar[XB_TMO], 1u); break; } }
    }
    nloc = mine > 0u ? mine : 1u; nx = cnt > 0u ? cnt : 1u;
}
__device__ __forceinline__ void xcd_barrier(const XcdBarrier& b) {
    asm volatile("s_waitcnt vmcnt(0)" ::: "memory");
    __syncthreads();
    if (threadIdx.x == 0) {
        unsigned* bar = b.bar;
        __builtin_amdgcn_s_waitcnt(0);
        unsigned nloc = b.st[0], nx = b.st[1];
        if (nloc == 0u) { xcd_barrier_complete(bar, b.x, nloc, nx); b.st[0] = nloc; b.st[1] = nx; }
        const unsigned old = xb_add(&bar[XB_XSUB(b.x)], 1u);
        const unsigned gen = old / nloc;
        if (old + 1u == (gen + 1u) * nloc) {
            __builtin_amdgcn_fence(__ATOMIC_RELEASE, "agent");
            asm volatile("s_waitcnt vmcnt(0)" ::: "memory");
            const unsigned og = xb_add(&bar[XB_TOP], 1u);
            const unsigned tg = og / nx;
            if (og + 1u == (tg + 1u) * nx) xb_add(&bar[XB_TOPGEN], 1u);
            else XB_SPIN(xb_ld(&bar[XB_TOPGEN]) == tg, bar);
            __builtin_amdgcn_fence(__ATOMIC_ACQUIRE, "agent");
            xb_add(&bar[XB_XGEN(b.x)], 1u);
            asm volatile("s_waitcnt vmcnt(0)" ::: "memory");
        } else {
            XB_SPIN(xb_ld(&bar[XB_XGEN(b.x)]) == gen, bar);
            __builtin_amdgcn_fence(__ATOMIC_ACQUIRE, "agent");
            asm volatile("s_waitcnt vmcnt(0)" ::: "memory");
        }
    }
    __syncthreads();
}

__global__ void __launch_bounds__(NTHR) fwd_megakernel(Args args) {
    extern __shared__ __attribute__((aligned(16))) unsigned char lds[];
    cg::grid_group grid = cg::this_grid();
    const int tid = threadIdx.x, lane = tid & 63, wave = __builtin_amdgcn_readfirstlane(tid >> 6);
    const int lo = args.ph_lo, hi = args.ph_hi;
    unsigned char* ws = args.ws;
    if (tid < 16) ((LAS unsigned*)((LAS unsigned char*)lds + LDS_BARST))[tid] = 0u;
    __syncthreads();
    XcdBarrier bar = xcd_barrier_post((unsigned*)(ws + WS_BAR), (volatile LAS unsigned*)((LAS unsigned char*)lds + LDS_BARST));
    if (hi > 1000) grid.sync();
#define IN(k) (lo <= (k) && (k) < hi)
#if defined(PROBE_A)
    unsigned long long ts[9]; ts[0] = __builtin_amdgcn_s_memrealtime();
#define SEAM(k) do { if (IN(k) && IN((k) + 1)) xcd_barrier(bar); ts[(k) + 1] = __builtin_amdgcn_s_memrealtime(); } while (0)
#else
#define SEAM(k) do { if (IN(k) && IN((k) + 1)) { xcd_barrier(bar); if (PROBE_DUP == 8) xcd_barrier(bar); } } while (0)
#endif
    if (IN(0)) { p0_prologue(args, lds, tid, lane, wave); if (PROBE_DUP == 0) { __syncthreads(); p0_prologue(args, lds, tid, lane, wave); } }
    SEAM(0);
    if (IN(1)) { pg8::Gemm g{(const bf16*)(ws + WS_XB), (const bf16*)(ws + WS_WIN), T, NIN, DM, DM, DM}; pg8::StaticOrder S; S.init(T, NIN, gridDim.x, blockIdx.x);
        pg8::EpiProj E{(bf16*)(ws + WS_PROJ), LDP, (const float*)(ws + WS_RSTD)};
        pg8::gemm_phase<pg8::EpiProj, pg8::StaticOrder>((PG8_LAS unsigned char*)lds, g, S, E);
        if (PROBE_DUP == 1) pg8::gemm_phase<pg8::EpiProj, pg8::StaticOrder>((PG8_LAS unsigned char*)lds, g, S, E); }
    SEAM(1);
    if (IN(2)) { if (PROBE_DUP == 2) { p2_tokenlocal(args, lds, tid, lane, wave, true); __syncthreads(); } p2_tokenlocal(args, lds, tid, lane, wave); }
    SEAM(2);
    if (IN(3)) { p3_kvlocal(args, lds, tid, lane, wave); if (PROBE_DUP == 3) p3_kvlocal(args, lds, tid, lane, wave); }
    SEAM(3);
    if (IN(4)) p4_scan(args, tid);
    SEAM(4);
    if (IN(5)) { if (PROBE_DUP == 5) p5_mlstm_out(args, lds, tid, lane, wave, true); p5_mlstm_out(args, lds, tid, lane, wave); }
    SEAM(5);
    if (IN(6)) { pg8::Gemm g{(const bf16*)(ws + WS_PROJ) + C_PZ, (const bf16*)(ws + WS_WOUT), T, DM, 2048, LDP, 2048}; pg8::StaticOrder S; S.init(T, DM, gridDim.x, blockIdx.x);
        pg8::EpiResid E{args.in[I_X], args.out, DM};
        pg8::gemm_phase<pg8::EpiResid, pg8::StaticOrder>((PG8_LAS unsigned char*)lds, g, S, E);
        if (PROBE_DUP == 6) pg8::gemm_phase<pg8::EpiResid, pg8::StaticOrder>((PG8_LAS unsigned char*)lds, g, S, E); }
    SEAM(6);
    if (IN(7)) { if (PROBE_DUP == 7) p7_final_norm(args, lane, wave, true); p7_final_norm(args, lane, wave); }
#if defined(PROBE_A)
    grid.sync(); ts[8] = __builtin_amdgcn_s_memrealtime();
    if (blockIdx.x == 0) { const float tA = (float)(ts[PROBE_A + 1] - ts[PROBE_A]) * 0.01f, tB = (float)(ts[PROBE_B + 1] - ts[PROBE_B]) * 0.01f;
        if (tid == 0) args.out[0] += tA;
        for (int i = tid; i < 1600; i += NTHR) args.out[4096 + i] += tB * 0.25f; }
#endif
#undef IN
#undef SEAM
}

extern "C" void kernel_launch(void* const* d_in, const int* in_sizes, int n_in, void* d_out, int out_size, void* d_ws, size_t ws_size, hipStream_t stream) {
    static int grid = 0;
    if (grid == 0) {
        if (n_in != 16 || in_sizes[0] != T * DM || out_size != T * DM || ws_size < WS_END) { fprintf(stderr, "kernel_launch: unexpected shapes (n_in %d, ws %zu)\n", n_in, ws_size); grid = -1; return; }
        int dev = 0, cus = 0, per_cu = 0;
        hipGetDevice(&dev); hipDeviceGetAttribute(&cus, hipDeviceAttributeMultiprocessorCount, dev);
        hipFuncSetAttribute((const void*)fwd_megakernel, hipFuncAttributeMaxDynamicSharedMemorySize, LDS_BYTES);
        if (hipOccupancyMaxActiveBlocksPerMultiprocessor(&per_cu, (const void*)fwd_megakernel, NTHR, LDS_BYTES) != hipSuccess || per_cu < 1) { fprintf(stderr, "kernel_launch: occupancy query says %d blocks/CU\n", per_cu); per_cu = 1; }
        (void)hipGetLastError();
        grid = cus * 1;
        if (grid <= 0) grid = 256;
    }
    if (grid < 0) return;
    Args a{};
    for (int i = 0; i < 16; ++i) a.in[i] = (const float*)d_in[i];
    a.out = (float*)d_out; a.ws = (unsigned char*)d_ws;
#if MK_MULTI
    for (int ph = 0; ph < 8; ++ph) { a.ph_lo = ph; a.ph_hi = ph + 1; hipLaunchKernelGGL(fwd_megakernel, dim3(grid), dim3(NTHR), LDS_BYTES, stream, a); }
#else
    a.ph_lo = 0; a.ph_hi = 8;
    if (hipMemsetAsync((char*)d_ws + WS_BAR, 0, BAR_BYTES, stream) != hipSuccess) fprintf(stderr, "kernel_launch: memset of barrier words failed\n");
    void* kargs[] = {&a};
    hipError_t e = hipLaunchCooperativeKernel((const void*)fwd_megakernel, dim3(grid), dim3(NTHR), kargs, LDS_BYTES, stream);
    if (e != hipSuccess) fprintf(stderr, "cooperative launch failed: %s (grid %d)\n", hipGetErrorString(e), grid);
#endif
}
```
